# Optimizing an MI355X kernel written in HIP

```python
import math
import jax, jax.numpy as jnp
from jax import lax
import numpy as np

D_MODEL = 1024
BATCH = 8
SEQ = 2048
DEPTH = 4

CHUNK = 64
Q_BLOCK = 128

ATTN_HEADS = 4
ATTN_WIDTH = D_MODEL // 2
ATTN_HEAD_DIM = ATTN_WIDTH // (2 * ATTN_HEADS)

POOL_WINDOWS = (2, 4, 8, 16)
POOL_GROUPS = len(POOL_WINDOWS)
POOL_WIDTH = D_MODEL // 4
POOL_GROUP_DIM = POOL_WIDTH // POOL_GROUPS

LRU_WIDTH = D_MODEL // 4
LRU_BLOCKS = 4
LRU_BLOCK_DIM = LRU_WIDTH // LRU_BLOCKS
LRU_C = 8.0
CONV_WIDTH = 4

MIX_WIDTH = ATTN_WIDTH + POOL_WIDTH + LRU_WIDTH
IN_WIDTH = 3 * ATTN_WIDTH + POOL_WIDTH + 2 * LRU_WIDTH
IN_SPLITS = (ATTN_WIDTH, 2 * ATTN_WIDTH, 3 * ATTN_WIDTH,
             3 * ATTN_WIDTH + POOL_WIDTH, 3 * ATTN_WIDTH + POOL_WIDTH + LRU_WIDTH)

D_FF = ((8 * D_MODEL // 3 + 127) // 128) * 128
N_EXPERTS = 8
TOP_K = 2
MOE_BLOCK = 256

LN_EPS = 1e-5
HEAD_NORM_EPS = 1e-5

kernel_name = 'hybrid_diffattn_pool_rglru_moe_deepnorm'


def _layer_norm(x, g, b):
    xf = x.astype(jnp.float32)
    mu = jnp.mean(xf, axis=-1, keepdims=True)
    var = jnp.mean(jnp.square(xf - mu), axis=-1, keepdims=True)
    return ((xf - mu) * lax.rsqrt(var + LN_EPS) * g + b).astype(x.dtype)


def _diff_attention(q, k, v, lam, subln_g, lambda_init):
    B, S = q.shape[0], q.shape[1]
    scale = ATTN_HEAD_DIM ** -0.5
    outs = []
    for blk in range(S // Q_BLOCK):
        q0 = blk * Q_BLOCK
        k_end = q0 + Q_BLOCK
        qb = q[:, q0:k_end]
        kb = k[:, :k_end]
        vb = v[:, :k_end]
        s = jnp.einsum('bqhmd,bkhmd->bhmqk', qb, kb).astype(jnp.float32) * scale
        q_chunk = (q0 + jnp.arange(Q_BLOCK)) // CHUNK
        k_chunk = jnp.arange(k_end) // CHUNK
        mask = k_chunk[None, :] <= q_chunk[:, None]
        s = jnp.where(mask, s, -jnp.inf)
        p = jax.nn.softmax(s, axis=-1)
        p_diff = p[:, :, 0] - lam * p[:, :, 1]
        outs.append(jnp.einsum('bhqk,bkhe->bqhe', p_diff.astype(v.dtype), vb))
    o = jnp.concatenate(outs, axis=1).astype(jnp.float32)
    o = o * lax.rsqrt(jnp.mean(jnp.square(o), axis=-1, keepdims=True) + HEAD_NORM_EPS)
    o = o * subln_g * (1.0 - lambda_init)
    return o.reshape(B, S, ATTN_WIDTH).astype(v.dtype)


def _pool_mixer(u, pool_w, pool_scale):
    B, S, _ = u.shape
    ug = u.reshape(B, S, POOL_GROUPS, POOL_GROUP_DIM)
    c = jnp.cumsum(ug.astype(jnp.float32), axis=1)
    c = jnp.pad(c, ((0, 0), (1, 0), (0, 0), (0, 0)))
    t = jnp.arange(S)
    win = jnp.array(POOL_WINDOWS, dtype=jnp.int32)
    lo = jnp.maximum(t[:, None] + 1 - win[None, :], 0)
    grp = jnp.arange(POOL_GROUPS)
    window_sum = c[:, 1:] - c[:, lo, grp]
    count = (t[:, None] + 1 - lo).astype(jnp.float32)
    pooled = window_sum / count[None, :, :, None] - ug.astype(jnp.float32)
    y = jnp.einsum('bsgc,gcd->bsgd', pooled.astype(u.dtype), pool_w)
    return y.reshape(B, S, POOL_WIDTH) * pool_scale


def _linear_combine(left, right):
    a_l, b_l = left
    a_r, b_r = right
    return a_l * a_r, a_r * b_l + b_r


def _rglru_mixer(xr, xg, conv_w, conv_b, w_a, b_a, w_i, b_i, lam):
    B, S, W = xr.shape
    xp = jnp.pad(xr, ((0, 0), (CONV_WIDTH - 1, 0), (0, 0)))
    xc = conv_b + xp[:, 0:S] * conv_w[0]
    for j in range(1, CONV_WIDTH):
        xc = xc + xp[:, j:j + S] * conv_w[j]
    xb = xc.reshape(B, S, LRU_BLOCKS, LRU_BLOCK_DIM)
    r = jax.nn.sigmoid((jnp.einsum('bshc,hcd->bshd', xb, w_a).reshape(B, S, W) + b_a).astype(jnp.float32))
    i = jax.nn.sigmoid((jnp.einsum('bshc,hcd->bshd', xb, w_i).reshape(B, S, W) + b_i).astype(jnp.float32))
    log_a = -LRU_C * r * jax.nn.softplus(-lam.astype(jnp.float32))
    a = jnp.exp(log_a)
    bterm = jnp.sqrt(-jnp.expm1(2.0 * log_a)) * (i * xc.astype(jnp.float32))
    _, h = lax.associative_scan(_linear_combine, (a, bterm), axis=1)
    return h.astype(xr.dtype) * jax.nn.gelu(xg)


def _swiglu(x, w_gate, w_up, w_down):
    return (jax.nn.silu(x @ w_gate) * (x @ w_up)) @ w_down


def _moe_swiglu(x, w_router, w_gate, w_up, w_down):
    B, S, D = x.shape
    xt = x.reshape(-1, D)
    T = xt.shape[0]
    P = T * TOP_K
    logits = (xt @ w_router).astype(jnp.float32)
    top_logit, top_e = lax.top_k(logits, TOP_K)
    gate = jax.nn.softmax(top_logit, axis=-1)
    flat_e = top_e.reshape(-1)
    order = jnp.argsort(flat_e)
    e_sorted = flat_e[order]
    tok = order // TOP_K
    sizes = jnp.bincount(flat_e, length=N_EXPERTS)
    padded = (sizes + MOE_BLOCK - 1) // MOE_BLOCK * MOE_BLOCK
    start = jnp.cumsum(sizes) - sizes
    pstart = jnp.cumsum(padded) - padded
    dest = pstart[e_sorted] + jnp.arange(P) - start[e_sorted]
    n_blocks = -(-P // MOE_BLOCK) + N_EXPERTS
    rows = jnp.zeros((n_blocks * MOE_BLOCK, D), x.dtype).at[dest].set(xt[tok])
    block_start = jnp.arange(n_blocks) * MOE_BLOCK
    block_e = jnp.minimum(jnp.sum(jnp.cumsum(padded)[None, :] <= block_start[:, None], axis=1), N_EXPERTS - 1)

    def expert_block(args):
        xb, e = args
        return _swiglu(xb, w_gate[e], w_up[e], w_down[e])

    ys = lax.map(expert_block, (rows.reshape(n_blocks, MOE_BLOCK, D), block_e)).reshape(-1, D)
    contrib = ys[dest] * gate.reshape(-1)[order][:, None].astype(x.dtype)
    return jnp.zeros_like(xt).at[tok].add(contrib).reshape(B, S, D)


def setup_inputs(seed: int = 0) -> dict:
    key = jax.random.key(seed)
    ks = iter(jax.random.split(key, 32))
    n_dense = (DEPTH + 1) // 2
    n_moe = DEPTH // 2
    beta = (8.0 * DEPTH) ** -0.25
    f32 = jnp.float32

    def nrm(shape, fan_in, scale=1.0):
        return jax.random.normal(next(ks), shape, f32) * (scale * fan_in ** -0.5)

    def noise(shape, s):
        return jax.random.normal(next(ks), shape, f32) * s

    x = jax.random.normal(next(ks), (BATCH, SEQ, D_MODEL), f32)
    col_scale = jnp.concatenate([
        jnp.ones((2 * ATTN_WIDTH,), f32),
        jnp.full((ATTN_WIDTH + POOL_WIDTH + LRU_WIDTH,), beta, f32),
        jnp.ones((LRU_WIDTH,), f32)])
    w_in = nrm((DEPTH, D_MODEL, IN_WIDTH), D_MODEL) * col_scale
    w_out = nrm((DEPTH, MIX_WIDTH, D_MODEL), MIX_WIDTH, beta)
    attn_lambda = noise((DEPTH, 4, ATTN_HEAD_DIM), 0.1)
    attn_subln_g = 1.0 + noise((DEPTH, 2 * ATTN_HEAD_DIM), 0.02)
    pool_w = nrm((DEPTH, POOL_GROUPS, POOL_GROUP_DIM, POOL_GROUP_DIM), POOL_GROUP_DIM)
    pool_scale = 1.0 + noise((DEPTH, POOL_WIDTH), 0.02)
    conv_w = nrm((DEPTH, CONV_WIDTH, LRU_WIDTH), CONV_WIDTH)
    conv_b = noise((DEPTH, LRU_WIDTH), 0.02)
    lru_wa = nrm((DEPTH, LRU_BLOCKS, LRU_BLOCK_DIM, LRU_BLOCK_DIM), LRU_BLOCK_DIM)
    lru_ba = noise((DEPTH, LRU_WIDTH), 0.02)
    lru_wi = nrm((DEPTH, LRU_BLOCKS, LRU_BLOCK_DIM, LRU_BLOCK_DIM), LRU_BLOCK_DIM)
    lru_bi = noise((DEPTH, LRU_WIDTH), 0.02)
    a_c = jax.random.uniform(next(ks), (DEPTH, LRU_WIDTH), f32, 0.9, 0.999)
    a0 = a_c ** (1.0 / LRU_C)
    lru_lambda = jnp.log(a0) - jnp.log1p(-a0)
    ln1_g = 1.0 + noise((DEPTH, D_MODEL), 0.02)
    ln1_b = noise((DEPTH, D_MODEL), 0.02)
    ln2_g = 1.0 + noise((DEPTH, D_MODEL), 0.02)
    ln2_b = noise((DEPTH, D_MODEL), 0.02)
    ffn_w_gate = nrm((n_dense, D_MODEL, D_FF), D_MODEL, beta)
    ffn_w_up = nrm((n_dense, D_MODEL, D_FF), D_MODEL, beta)
    ffn_w_down = nrm((n_dense, D_FF, D_MODEL), D_FF, beta)
    router_w = nrm((n_moe, D_MODEL, N_EXPERTS), D_MODEL)
    moe_w_gate = nrm((n_moe, N_EXPERTS, D_MODEL, D_FF), D_MODEL, beta)
    moe_w_up = nrm((n_moe, N_EXPERTS, D_MODEL, D_FF), D_MODEL, beta)
    moe_w_down = nrm((n_moe, N_EXPERTS, D_FF, D_MODEL), D_FF, beta)
    return {'x': x, 'w_in': w_in, 'w_out': w_out, 'attn_lambda': attn_lambda,
            'attn_subln_g': attn_subln_g, 'pool_w': pool_w, 'pool_scale': pool_scale,
            'conv_w': conv_w, 'conv_b': conv_b, 'lru_wa': lru_wa, 'lru_ba': lru_ba,
            'lru_wi': lru_wi, 'lru_bi': lru_bi, 'lru_lambda': lru_lambda,
            'ln1_g': ln1_g, 'ln1_b': ln1_b, 'ln2_g': ln2_g, 'ln2_b': ln2_b,
            'ffn_w_gate': ffn_w_gate, 'ffn_w_up': ffn_w_up, 'ffn_w_down': ffn_w_down,
            'router_w': router_w, 'moe_w_gate': moe_w_gate, 'moe_w_up': moe_w_up,
            'moe_w_down': moe_w_down}


def reference(x, w_in, w_out, attn_lambda, attn_subln_g, pool_w, pool_scale,
              conv_w, conv_b, lru_wa, lru_ba, lru_wi, lru_bi, lru_lambda,
              ln1_g, ln1_b, ln2_g, ln2_b, ffn_w_gate, ffn_w_up, ffn_w_down,
              router_w, moe_w_gate, moe_w_up, moe_w_down):
    alpha = (2.0 * DEPTH) ** 0.25
    B, S, _ = x.shape
    for l in range(DEPTH):
        h = x @ w_in[l]
        q, k, v, u, xr, xg = jnp.split(h, IN_SPLITS, axis=-1)
        q = q.reshape(B, S, ATTN_HEADS, 2, ATTN_HEAD_DIM)
        k = k.reshape(B, S, ATTN_HEADS, 2, ATTN_HEAD_DIM)
        v = v.reshape(B, S, ATTN_HEADS, 2 * ATTN_HEAD_DIM)
        lambda_init = 0.8 - 0.6 * math.exp(-0.3 * l)
        lv = attn_lambda[l].astype(jnp.float32)
        lam = jnp.exp(jnp.sum(lv[0] * lv[1])) - jnp.exp(jnp.sum(lv[2] * lv[3])) + lambda_init
        y_attn = _diff_attention(q, k, v, lam, attn_subln_g[l], lambda_init)
        y_pool = _pool_mixer(u, pool_w[l], pool_scale[l])
        y_lru = _rglru_mixer(xr, xg, conv_w[l], conv_b[l], lru_wa[l], lru_ba[l],
                             lru_wi[l], lru_bi[l], lru_lambda[l])
        mix = jnp.concatenate([y_attn, y_pool, y_lru], axis=-1) @ w_out[l]
        x = _layer_norm(alpha * x + mix, ln1_g[l], ln1_b[l])
        if l % 2 == 0:
            f = _swiglu(x, ffn_w_gate[l // 2], ffn_w_up[l // 2], ffn_w_down[l // 2])
        else:
            f = _moe_swiglu(x, router_w[l // 2], moe_w_gate[l // 2], moe_w_up[l // 2], moe_w_down[l // 2])
        x = _layer_norm(alpha * x + f, ln2_g[l], ln2_b[l])
    return x
```

```cpp
#include <hip/hip_runtime.h>
#include <hip/hip_cooperative_groups.h>
#include <cstdio>
#include <cstdint>
#include <cmath>
namespace cg = cooperative_groups;
namespace pg8 {
#define PG8_LAS __attribute__((address_space(3)))
typedef unsigned short bf16_t;
typedef short bf16x8 __attribute__((ext_vector_type(8)));
typedef float f32x4 __attribute__((ext_vector_type(4)));
typedef unsigned u32x4 __attribute__((ext_vector_type(4)));
constexpr int BM = 256, BK = 64, HALF = 128, HTB = HALF * BK * 2  , STAGE_BYTES = 8 * HTB, NXCD = 8, WGM = 8;

__host__ __device__ __forceinline__ int lds_byte(int r, int c) { const int st = (r >> 4) * 2 + (c >> 5), rr = r & 15, cc = c & 31, ob = rr * 64 + cc * 2; return st * 1024 + (ob ^ (((ob >> 9) & 1) << 5)); }
__host__ __device__ __forceinline__ void stage_rc(int b, int& R, int& C) { const int st = b / 1024, sb = b % 1024, swz = sb ^ (((sb >> 9) & 1) << 5); R = (st >> 1) * 16 + swz / 64; C = (st & 1) * 32 + (swz % 64) / 2; }
__host__ __device__ __forceinline__ int perm32(int rho) { const int n = rho >> 4, i = rho & 15; return 8 * (i >> 2) + 4 * n + (i & 3); }

struct Unit { int pm, pn, kz; };
struct Gemm { const bf16_t* A; const bf16_t* Bt; int M, N, K, ld; };

struct StaticOrder {
    int nM, nN, nwg, G, c;
    __host__ __device__ void init(int M, int N, int G_, int c_) { nM = M / BM; nN = N / BM; nwg = nM * nN; G = G_; c = c_; }
    __host__ __device__ bool next(int i, Unit& u) const {
        const long L = (long)i * G + c; if (L >= nwg) return false;
        int wgid = (int)L; { const int q = nwg / NXCD, r = nwg % NXCD, xcd = wgid % NXCD, off = wgid / NXCD; wgid = (xcd < r ? xcd * (q + 1) : r * (q + 1) + (xcd - r) * q) + off; }
        const int nig = WGM * nN, gid = wgid / nig, fm = gid * WGM, gsz = (nM - fm) < WGM ? (nM - fm) : WGM;
        u.pm = fm + ((wgid % nig) % gsz); u.pn = (wgid % nig) / gsz; u.kz = 0; return true;
    }
    __device__ __forceinline__ void a_ready(const Unit&) const {}
    __device__ __forceinline__ void done(const Unit&) const {}
};

__device__ __forceinline__ unsigned cvt_pk_bf16(float lo, float hi) { unsigned r; asm volatile("v_cvt_pk_bf16_f32 %0, %1, %2" : "=v"(r) : "v"(lo), "v"(hi)); return r; }
typedef float f32x2 __attribute__((ext_vector_type(2)));
template <class Epi, class Sched, bool ALIGN_EPI = false, bool SP2 = false>
__device__ __forceinline__ void gemm_phase(PG8_LAS unsigned char* lds, const Gemm g, const Sched& S, const Epi& E) {
    int tid_ = threadIdx.x; asm volatile("" : "+v"(tid_));
    const int tid = tid_, wid = __builtin_amdgcn_readfirstlane(tid >> 6), lane = tid & 63, wr = wid >> 2, wc = wid & 3, fr = lane & 15, fq = lane >> 4;
    const int K = g.ld, nt = g.K / BK;
    unsigned voffA[2], voffB[2];
#pragma unroll
    for (int i = 0; i < 2; ++i) { int R, C; stage_rc(tid * 16 + i * 8192, R, C); const int Rb = Epi::PERM ? ((R & ~31) + perm32(R & 31)) : R;
        voffA[i] = (unsigned)(R * K + C) * 2u; voffB[i] = (unsigned)(Rb * K + C) * 2u; }
    const size_t kstep = (size_t)(BK * 2);
    const size_t hstep = (size_t)HALF * K * 2;
    const size_t tstep = 2 * hstep;
    const unsigned ldsw = (unsigned)wid * 1024u;
    const int aoff = lds_byte(wr * 64 + fr, fq * 8), boff = lds_byte(wc * 32 + fr, fq * 8);
#define PG8_SA(b, h) (((b) * 2 + (h)) * HTB)
#define PG8_SB(b, h) ((4 + (b) * 2 + (h)) * HTB)
#define PG8_STAGE(bufoff, gbase, voff) do { _Pragma("unroll") for (int _i = 0; _i < 2; ++_i) \
        __builtin_amdgcn_global_load_lds((const unsigned*)((const char*)(gbase) + (voff)[_i]), (PG8_LAS unsigned*)(lds + (bufoff) + ldsw + _i * 8192), 16, 0, 0); } while (0)
#define PG8_LDA(dst, b, h) do { _Pragma("unroll") for (int m = 0; m < 4; ++m) _Pragma("unroll") for (int k = 0; k < 2; ++k) dst[m][k] = *(const PG8_LAS bf16x8*)(lds + PG8_SA(b, h) + aoff + m * 2048 + k * 1024); } while (0)
#define PG8_LDB(dst, b, h) do { _Pragma("unroll") for (int n = 0; n < 2; ++n) _Pragma("unroll") for (int k = 0; k < 2; ++k) dst[n][k] = *(const PG8_LAS bf16x8*)(lds + PG8_SB(b, h) + boff + n * 2048 + k * 1024); } while (0)
#define PG8_MMA(ai, bj, At, Bt) do { __builtin_amdgcn_s_setprio(1); _Pragma("unroll") for (int m = 0; m < 4; ++m) _Pragma("unroll") for (int n = 0; n < 2; ++n) _Pragma("unroll") for (int k = 0; k < 2; ++k) \
        acc[ai][bj][m][n] = __builtin_amdgcn_mfma_f32_16x16x32_bf16(Bt[n][k], At[m][k], acc[ai][bj][m][n], 0, 0, 0); __builtin_amdgcn_s_setprio(0); } while (0)
#define PG8_WAIT_V(n) asm volatile("s_waitcnt vmcnt(" #n ")" ::: "memory")
#define PG8_WAIT_L(n) asm volatile("s_waitcnt lgkmcnt(" #n ")" ::: "memory")
#define PG8_BAR __builtin_amdgcn_s_barrier()
#define PG8_SCHED __builtin_amdgcn_sched_barrier(0)
    Unit cur, nxt; int ui = 0;
    if (!S.next(0, cur)) return;
    f32x4 acc[2][2][4][2];
#pragma unroll
    for (int a = 0; a < 2; ++a)
#pragma unroll
        for (int b = 0; b < 2; ++b)
#pragma unroll
            for (int m = 0; m < 4; ++m)
#pragma unroll
                for (int n = 0; n < 2; ++n) acc[a][b][m][n] = (f32x4){0.f, 0.f, 0.f, 0.f};
    bf16x8 At[4][2], B0[2][2], B1[2][2];
    const char* cA = (const char*)g.A + (size_t)cur.pm * tstep + (size_t)cur.kz * 2; const char* cB = (const char*)g.Bt + (size_t)cur.pn * tstep + (size_t)cur.kz * 2;
    S.a_ready(cur);
    if constexpr (SP2) {
        PG8_STAGE(PG8_SB(0, 0), cB, voffB); PG8_STAGE(PG8_SB(0, 1), cB + hstep, voffB); PG8_STAGE(PG8_SA(0, 0), cA, voffA); PG8_STAGE(PG8_SA(0, 1), cA + hstep, voffA);
        if (wr == 1) PG8_BAR;
        PG8_WAIT_V(2); PG8_BAR;
        PG8_STAGE(PG8_SB(1, 0), cB + kstep, voffB); PG8_STAGE(PG8_SA(1, 0), cA + kstep, voffA); PG8_STAGE(PG8_SB(1, 1), cB + hstep + kstep, voffB);
        PG8_WAIT_V(6); PG8_BAR;
    } else {
        PG8_STAGE(PG8_SB(0, 0), cB, voffB); PG8_STAGE(PG8_SA(0, 0), cA, voffA); PG8_STAGE(PG8_SB(0, 1), cB + hstep, voffB); PG8_STAGE(PG8_SA(0, 1), cA + hstep, voffA);
        if (wr == 1) PG8_BAR;
        PG8_WAIT_V(4); PG8_BAR;
        PG8_STAGE(PG8_SB(1, 0), cB + kstep, voffB); PG8_STAGE(PG8_SA(1, 0), cA + kstep, voffA); PG8_STAGE(PG8_SB(1, 1), cB + hstep + kstep, voffB);
        PG8_WAIT_V(6); PG8_BAR;
    }
    for (;;) {
        const bool has_next = S.next(ui + 1, nxt);
        const char* nA = has_next ? (const char*)g.A + (size_t)nxt.pm * tstep + (size_t)nxt.kz * 2 : cA; const char* nB = has_next ? (const char*)g.Bt + (size_t)nxt.pn * tstep + (size_t)nxt.kz * 2 : cB;
        for (int t = 0; t < nt; t += 2) {
            const bool last = (t == nt - 2);
            const char* a1 = cA + (size_t)(t + 1) * kstep;
            const char* a2 = last ? nA : cA + (size_t)(t + 2) * kstep; const char* b2 = last ? nB : cB + (size_t)(t + 2) * kstep;
            const char* a3 = a2 + kstep; const char* b3 = b2 + kstep;
            if (last && has_next) S.a_ready(nxt);
            if constexpr (SP2) {
            PG8_LDB(B0, 0, 0); PG8_LDB(B1, 0, 1); PG8_SCHED; PG8_LDA(At, 0, 0); PG8_STAGE(PG8_SA(1, 1), a1 + hstep, voffA);
            PG8_WAIT_V(8); PG8_WAIT_L(0); PG8_BAR; PG8_MMA(0, 0, At, B0); PG8_MMA(0, 1, At, B1); PG8_BAR; PG8_SCHED;
            PG8_LDA(At, 0, 1); PG8_STAGE(PG8_SB(0, 0), b2, voffB); PG8_STAGE(PG8_SB(0, 1), b2 + hstep, voffB); PG8_STAGE(PG8_SA(0, 0), a2, voffA);
            PG8_WAIT_V(8); PG8_WAIT_L(0); PG8_BAR; PG8_MMA(1, 0, At, B0); PG8_MMA(1, 1, At, B1); PG8_BAR; PG8_SCHED;
            PG8_LDB(B0, 1, 0); PG8_LDB(B1, 1, 1); PG8_SCHED; PG8_LDA(At, 1, 0); PG8_STAGE(PG8_SA(0, 1), a2 + hstep, voffA);
            PG8_WAIT_V(8); PG8_WAIT_L(0); PG8_BAR; PG8_MMA(0, 0, At, B0); PG8_MMA(0, 1, At, B1); PG8_BAR; PG8_SCHED;
            PG8_LDA(At, 1, 1); PG8_STAGE(PG8_SB(1, 0), b3, voffB); PG8_STAGE(PG8_SB(1, 1), b3 + hstep, voffB); PG8_STAGE(PG8_SA(1, 0), a3, voffA);
            PG8_WAIT_V(8); PG8_WAIT_L(0); PG8_BAR; PG8_MMA(1, 0, At, B0); PG8_MMA(1, 1, At, B1); PG8_BAR; PG8_SCHED;
            } else {
            PG8_LDB(B0, 0, 0); PG8_SCHED; PG8_LDA(At, 0, 0); PG8_STAGE(PG8_SA(1, 1), a1 + hstep, voffA);
            PG8_WAIT_L(8); PG8_BAR; PG8_WAIT_L(0); PG8_MMA(0, 0, At, B0); PG8_BAR; PG8_SCHED;
            PG8_LDB(B1, 0, 1); PG8_STAGE(PG8_SB(0, 0), b2, voffB);
            PG8_BAR; PG8_WAIT_L(0); PG8_MMA(0, 1, At, B1); PG8_BAR;
            PG8_LDA(At, 0, 1); PG8_STAGE(PG8_SA(0, 0), a2, voffA);
            PG8_BAR; PG8_WAIT_L(0); PG8_MMA(1, 0, At, B0); PG8_BAR; PG8_SCHED;
            PG8_STAGE(PG8_SB(0, 1), b2 + hstep, voffB);
            PG8_WAIT_V(6); PG8_BAR; PG8_MMA(1, 1, At, B1); PG8_BAR;
            PG8_LDB(B0, 1, 0); PG8_SCHED; PG8_LDA(At, 1, 0); PG8_STAGE(PG8_SA(0, 1), a2 + hstep, voffA);
            PG8_WAIT_L(8); PG8_BAR; PG8_WAIT_L(0); PG8_MMA(0, 0, At, B0); PG8_BAR; PG8_SCHED;
            PG8_LDB(B1, 1, 1); PG8_STAGE(PG8_SB(1, 0), b3, voffB);
            PG8_BAR; PG8_WAIT_L(0); PG8_MMA(0, 1, At, B1); PG8_BAR;
            PG8_LDA(At, 1, 1); PG8_STAGE(PG8_SA(1, 0), a3, voffA);
            PG8_BAR; PG8_WAIT_L(0); PG8_MMA(1, 0, At, B0); PG8_BAR; PG8_SCHED;
            PG8_STAGE(PG8_SB(1, 1), b3 + hstep, voffB);
            PG8_WAIT_V(6); PG8_BAR; PG8_MMA(1, 1, At, B1); PG8_BAR;
            }
        }
        if constexpr (ALIGN_EPI) { if (wr == 0) PG8_BAR; }
        if constexpr (!Epi::AFTER_DRAIN) { E(acc, cur, wr, wc, fr, fq); S.done(cur); }
        if (!has_next) break;
#pragma unroll
        for (int a = 0; a < 2; ++a)
#pragma unroll
            for (int b = 0; b < 2; ++b)
#pragma unroll
                for (int m = 0; m < 4; ++m)
#pragma unroll
                    for (int n = 0; n < 2; ++n) acc[a][b][m][n] = (f32x4){0.f, 0.f, 0.f, 0.f};
        cur = nxt; cA = nA; cB = nB; ++ui;
        if constexpr (ALIGN_EPI) { if (wr == 1) PG8_BAR; }
    }
    PG8_WAIT_V(0);
    if constexpr (!ALIGN_EPI) { if (wr == 0) PG8_BAR; }
    PG8_BAR;
    if constexpr (Epi::AFTER_DRAIN) { E.fused(acc, cur, wr, wc, fr, fq, lds, wid, lane); S.done(cur); }
#undef PG8_SA
#undef PG8_SB
#undef PG8_STAGE
#undef PG8_LDA
#undef PG8_LDB
#undef PG8_MMA
#undef PG8_WAIT_V
#undef PG8_WAIT_L
#undef PG8_BAR
#undef PG8_SCHED
}
}

namespace pg8 {
__device__ __forceinline__ float silu_f(float x) { return x * __builtin_amdgcn_rcpf(1.0f + __expf(-x)); }
struct EpiStore {
    static constexpr bool PERM = true, AFTER_DRAIN = false;
    bf16_t* O; int ldc; int ntn;
    __device__ __forceinline__ void operator()(const f32x4 (&acc)[2][2][4][2], const Unit& u, int wr, int wc, int fr, int fq) const {
        const int row0 = u.pm * BM + wr * 64 + fr; const int col0 = (u.pn % ntn) * BM + wc * 32 + 8 * fq;
#pragma unroll
        for (int ai = 0; ai < 2; ++ai)
#pragma unroll
            for (int m = 0; m < 4; ++m) { bf16_t* rowp = O + (size_t)(row0 + ai * HALF + m * 16) * ldc + col0;
#pragma unroll
                for (int bj = 0; bj < 2; ++bj) { const f32x4 v0 = acc[ai][bj][m][0], v1 = acc[ai][bj][m][1];
                    u32x4 w; w.x = cvt_pk_bf16(v0[0], v0[1]); w.y = cvt_pk_bf16(v0[2], v0[3]); w.z = cvt_pk_bf16(v1[0], v1[1]); w.w = cvt_pk_bf16(v1[2], v1[3]);
                    *(u32x4*)(rowp + bj * HALF) = w; } }
    }
};
struct EpiSwiglu {
    static constexpr bool PERM = true, AFTER_DRAIN = false;
    bf16_t* O; int ldc; int ntn;
    __device__ __forceinline__ void operator()(const f32x4 (&acc)[2][2][4][2], const Unit& u, int wr, int wc, int fr, int fq) const {
        const int row0 = u.pm * BM + wr * 64 + fr; const int col0 = (u.pn % ntn) * HALF + wc * 32 + 8 * fq;
#pragma unroll
        for (int ai = 0; ai < 2; ++ai)
#pragma unroll
            for (int m = 0; m < 4; ++m) { bf16_t* rowp = O + (size_t)(row0 + ai * HALF + m * 16) * ldc + col0;
                const f32x4 g0 = acc[ai][0][m][0], g1 = acc[ai][0][m][1], u0 = acc[ai][1][m][0], u1 = acc[ai][1][m][1];
                u32x4 w;
                w.x = cvt_pk_bf16(silu_f(g0[0]) * u0[0], silu_f(g0[1]) * u0[1]); w.y = cvt_pk_bf16(silu_f(g0[2]) * u0[2], silu_f(g0[3]) * u0[3]);
                w.z = cvt_pk_bf16(silu_f(g1[0]) * u1[0], silu_f(g1[1]) * u1[1]); w.w = cvt_pk_bf16(silu_f(g1[2]) * u1[2], silu_f(g1[3]) * u1[3]);
                *(u32x4*)rowp = w; asm volatile("" ::: "memory"); }
    }
};
struct MoeOrder {
    StaticOrder so; int nN; int pe0, pe1, pe2, pe3, pe4, pe5, pe6, pe7;
    __device__ __forceinline__ bool next(int i, Unit& u) const {
        Unit t; if (!so.next(i, t)) return false;
        const int pm = t.pm;
        int e = (pe0 <= pm) + (pe1 <= pm) + (pe2 <= pm) + (pe3 <= pm) + (pe4 <= pm) + (pe5 <= pm) + (pe6 <= pm) + (pe7 <= pm);
        e = e > 7 ? 7 : e;
        u.pm = pm; u.pn = e * nN + t.pn; u.kz = 0; return true;
    }
    __device__ __forceinline__ void a_ready(const Unit&) const {}
    __device__ __forceinline__ void done(const Unit&) const {}
};
struct TailOrder {
    int nunits, ns, kslice, G, c, pm0, nNt, pn0, nNe; int pe0, pe1, pe2, pe3, pe4, pe5, pe6, pe7;
    __device__ __forceinline__ bool next(int i, Unit& u) const {
        const long L = (long)i * G + c; if (L >= (long)nunits * ns) return false;
        const int unit = (int)(L / ns), sl = (int)(L - (long)unit * ns);
        const int pm = pm0 + unit / nNt, pl = unit % nNt;
        int e = 0;
        if (nNe > 0) { e = (pe0 <= pm) + (pe1 <= pm) + (pe2 <= pm) + (pe3 <= pm) + (pe4 <= pm) + (pe5 <= pm) + (pe6 <= pm) + (pe7 <= pm); e = e > 7 ? 7 : e; }
        u.pm = pm; u.pn = pn0 + e * nNe + pl; u.kz = sl * kslice; return true;
    }
    __device__ __forceinline__ void a_ready(const Unit&) const {}
    __device__ __forceinline__ void done(const Unit&) const {}
};
struct EpiSlab {
    static constexpr bool PERM = false, AFTER_DRAIN = false;
    float* slab; size_t slab_stride; int ldc, pm0, pn0, ntn, kslice;
    __device__ __forceinline__ void operator()(const f32x4 (&acc)[2][2][4][2], const Unit& u, int wr, int wc, int fr, int fq) const {
        float* out = slab + (size_t)(u.kz / kslice) * slab_stride;
        const int row0 = (u.pm - pm0) * BM + wr * 64 + fr; const int col0 = ((u.pn - pn0) % ntn) * BM + wc * 32 + 4 * fq;
#pragma unroll
        for (int ai = 0; ai < 2; ++ai)
#pragma unroll
            for (int m = 0; m < 4; ++m) { const size_t off = (size_t)(row0 + ai * HALF + m * 16) * ldc + col0;
#pragma unroll
                for (int bj = 0; bj < 2; ++bj)
#pragma unroll
                    for (int n = 0; n < 2; ++n) *(f32x4*)(out + off + bj * HALF + n * 16) = acc[ai][bj][m][n]; }
    }
};
}

constexpr int NB = 8, SEQ = 2048, DM = 1024, TT = NB * SEQ, INW = 2304, FF = 2816, NEXP = 8, DEPTH = 4;
constexpr int MOE_MAXBLK = (2 * TT) / 256 + NEXP;
constexpr float LN_EPS = 1e-5f;
constexpr int NWAVES = 8, NTHR = 512;
constexpr size_t MiB = 1u << 20;
constexpr size_t WS_CTL = 0, CTL_BYTES = 256 * 1024;
constexpr size_t WS_AGG = 512 * 1024;
constexpr size_t WS_WIN = 1 * MiB;
constexpr size_t WS_TOK = 5 * MiB + 512 * 1024;
constexpr size_t WS_WOUT = 6 * MiB;
constexpr size_t WS_WGU = 8 * MiB;
constexpr size_t WS_WD = 96 * MiB;
constexpr size_t WS_X = 140 * MiB;
constexpr size_t WS_XB = 204 * MiB;
constexpr size_t WS_H = 236 * MiB;
constexpr size_t WS_MIX = 308 * MiB;
constexpr size_t WS_HID = 340 * MiB;
constexpr size_t WS_ROWS = 527 * MiB;
constexpr size_t WS_SLAB = 595 * MiB;
constexpr size_t WS_END = 683 * MiB;
constexpr int CW_CNT = 0;
constexpr int CW_FLAG = 1024;
constexpr int CW_BAR = 4096;

constexpr int LDS_BYTES = 147456;
constexpr int MISC_OFF = 140 * 1024;

#define LAS __attribute__((address_space(3)))
typedef unsigned short bf16;
typedef unsigned v4u __attribute__((ext_vector_type(4)));
typedef unsigned v2u __attribute__((ext_vector_type(2)));
typedef float f32x4 __attribute__((ext_vector_type(4)));
typedef short bf16x8 __attribute__((ext_vector_type(8)));
typedef short s16x4 __attribute__((ext_vector_type(4)));
typedef float f32x16 __attribute__((ext_vector_type(16)));
#define RLX_AGENT __ATOMIC_RELAXED, __HIP_MEMORY_SCOPE_AGENT

__device__ __forceinline__ unsigned pk2(float lo, float hi) { return pg8::cvt_pk_bf16(lo, hi); }
__device__ __forceinline__ float bflo(unsigned w) { return __uint_as_float(w << 16); }
__device__ __forceinline__ float bfhi(unsigned w) { return __uint_as_float(w & 0xffff0000u); }
__device__ __forceinline__ float shfl_xor_l(float v, int o, int lane) { return __int_as_float(__builtin_amdgcn_ds_bpermute((lane ^ o) << 2, __float_as_int(v))); }
__device__ __forceinline__ float wave_sum(float v, int lane) {
#pragma unroll
    for (int o = 1; o < 64; o <<= 1) v += shfl_xor_l(v, o, lane);
    return v;
}

struct Params { const float* in[25]; float* out; unsigned char* ws; int pad0, pad1; };
enum { I_X = 0, I_WIN, I_WOUT, I_ALAM, I_ASUB, I_POOLW, I_POOLS, I_CONVW, I_CONVB, I_WA, I_BA, I_WI, I_BI, I_LLAM, I_LN1G, I_LN1B, I_LN2G, I_LN2B,
       I_FG, I_FU, I_FD, I_ROUT, I_MG, I_MU, I_MD };

struct Frame {
    LAS unsigned char* lds;
    int tid, lane, wave, vcu, G;
};
__device__ __forceinline__ int fresh_s(int v) { asm volatile("" : "+s"(v)); return v; }
__device__ __forceinline__ Frame refresh(const Frame& F0) {
    Frame F; int t = threadIdx.x; asm volatile("" : "+v"(t));
    int vc = F0.vcu, g = F0.G; asm volatile("" : "+s"(vc), "+s"(g));
    F.lds = F0.lds; F.tid = t; F.lane = t & 63; F.wave = __builtin_amdgcn_readfirstlane(t >> 6); F.vcu = vc; F.G = g; return F;
}

__device__ __forceinline__ void transpose_item(const float* W, int K, int N, bf16* WT, int mode, LAS float* scr, int item, int lane) {
    const int nblk = N / 32, kb = item / nblk, nb = item % nblk, k0 = 64 * kb, n0 = 32 * nb;
    const int r0 = mode == 0 ? n0 : ((n0 >> 7) * 256 + (n0 & 127) + (mode == 2 ? 128 : 0));
#pragma unroll 8
    for (int i = 0; i < 32; ++i) { const int kk = 2 * i + (lane >> 5); scr[kk * 33 + (lane & 31)] = W[(size_t)(k0 + kk) * N + n0 + (lane & 31)]; }
    asm volatile("s_waitcnt lgkmcnt(0)" ::: "memory");
    const int c = lane & 7;
#pragma unroll
    for (int j = 0; j < 4; ++j) { const int n = (lane >> 3) + 8 * j; const LAS float* s = scr + (8 * c) * 33 + n;
        v4u o; o.x = pk2(s[0 * 33], s[1 * 33]); o.y = pk2(s[2 * 33], s[3 * 33]); o.z = pk2(s[4 * 33], s[5 * 33]); o.w = pk2(s[6 * 33], s[7 * 33]);
        *(v4u*)(WT + (size_t)(r0 + n) * K + k0 + 8 * c) = o; }
    asm volatile("s_waitcnt lgkmcnt(0)" ::: "memory");
}

__device__ __forceinline__ void prep_layer(const Frame& F0, const Params& p, int l) {
    const Frame F = refresh(F0);
    unsigned char* ws = p.ws;
    LAS float* scr = (LAS float*)(F.lds + F.wave * 16384);
    const int gw = F.vcu * NWAVES + F.wave, NGW = F.G * NWAVES;
    const bool moe = (l & 1);
    const int nexp = moe ? NEXP : 1;
    constexpr int I_IN = 16 * 72, I_OUT = 16 * 32, I_G = 16 * 88, I_D = 44 * 32, I_E = 2 * I_G + I_D;
    const int nitems = I_IN + I_OUT + nexp * I_E;
    bf16* WIN = (bf16*)(ws + WS_WIN); bf16* WOUT = (bf16*)(ws + WS_WOUT); bf16* WGU = (bf16*)(ws + WS_WGU); bf16* WD = (bf16*)(ws + WS_WD);
    const float* win = p.in[I_WIN] + (size_t)l * DM * INW;
    const float* wout = p.in[I_WOUT] + (size_t)l * DM * DM;
    const size_t esz = (size_t)DM * FF;
    const float* fg = moe ? p.in[I_MG] + (size_t)(l >> 1) * NEXP * esz : p.in[I_FG] + (size_t)(l >> 1) * esz;
    const float* fu = moe ? p.in[I_MU] + (size_t)(l >> 1) * NEXP * esz : p.in[I_FU] + (size_t)(l >> 1) * esz;
    const float* fd = moe ? p.in[I_MD] + (size_t)(l >> 1) * NEXP * esz : p.in[I_FD] + (size_t)(l >> 1) * esz;
    for (int it = gw; it < nitems; it += NGW) {
        int r = it;
        if (r < I_IN) { transpose_item(win, DM, INW, WIN, 0, scr, r, F.lane); continue; } r -= I_IN;
        if (r < I_OUT) { const int kb = r / 32; if (kb < 8 || kb >= 12) transpose_item(wout, DM, DM, WOUT, 0, scr, r, F.lane); continue; } r -= I_OUT;
        const int e = r / I_E; r -= e * I_E;
        if (r < I_G) { transpose_item(fg + e * esz, DM, FF, WGU + (size_t)e * 2 * esz, 1, scr, r, F.lane); continue; } r -= I_G;
        if (r < I_G) { transpose_item(fu + e * esz, DM, FF, WGU + (size_t)e * 2 * esz, 2, scr, r, F.lane); continue; } r -= I_G;
        transpose_item(fd + e * esz, FF, DM, WD + (size_t)e * esz, 0, scr, r, F.lane);
    }
    {
        const float* pw = p.in[I_POOLW] + (size_t)l * 4 * 64 * 64; const float* ps = p.in[I_POOLS] + (size_t)l * 256;
        for (int idx = F.vcu * NTHR + F.tid; idx < 256 * 1024; idx += F.G * NTHR) {
            const int n = idx & 1023, kc = idx >> 10, g = kc >> 6;
            const float* pr = pw + (size_t)kc * 64; const float* sc = ps + g * 64; const float* wo = wout + (size_t)(512 + g * 64) * DM + n;
            float a = 0.f;
#pragma unroll 8
            for (int d = 0; d < 64; ++d) a += pr[d] * sc[d] * wo[(size_t)d * DM];
            WOUT[(size_t)n * DM + 512 + kc] = (bf16)(pk2(a, 0.f) & 0xffffu);
        }
    }
    if (l == 0) {
        const float* x = p.in[I_X]; bf16* XB = (bf16*)(ws + WS_XB);
        for (int m = gw; m < TT; m += NGW) {
            const f32x4* xr = (const f32x4*)(x + (size_t)m * DM) + F.lane; v2u* o = (v2u*)(XB + (size_t)m * DM) + F.lane;
#pragma unroll
            for (int j = 0; j < 4; ++j) { const f32x4 v = xr[64 * j]; v2u w; w.x = pk2(v.x, v.y); w.y = pk2(v.z, v.w); o[64 * j] = w; }
        }
    }
}

template <bool COMB, bool ROUTER>
__device__ __forceinline__ void ln_phase(const Frame& F0, const float* src, float* dst, bf16* XB, const float* gam, const float* bet, float alpha,
                                         const bf16* Y, int* tok, const float* wr, unsigned* cnt, int* blkbase) {
    const Frame F = refresh(F0);
    const int gw = F.vcu * NWAVES + F.wave, NGW = F.G * NWAVES;
    f32x4 gv[4], bv[4];
#pragma unroll
    for (int j = 0; j < 4; ++j) { gv[j] = *((const f32x4*)gam + F.lane + 64 * j); bv[j] = *((const f32x4*)bet + F.lane + 64 * j); }
    f32x4 rw[4][4][2];
    LAS unsigned* lcnt = (LAS unsigned*)(F.lds + MISC_OFF + 256);
    if (ROUTER) {
        if (F.tid < 8) lcnt[F.tid] = 0u;
        __syncthreads();
#pragma unroll
        for (int j = 0; j < 4; ++j)
#pragma unroll
            for (int i = 0; i < 4; ++i) { const int col = 4 * F.lane + 256 * j + i; rw[j][i][0] = *(const f32x4*)(wr + (size_t)col * 8); rw[j][i][1] = *(const f32x4*)(wr + (size_t)col * 8 + 4); }
    }
    for (int row = gw; row < TT; row += NGW) {
        f32x4 v[4];
#pragma unroll
        for (int j = 0; j < 4; ++j) v[j] = *((const f32x4*)(src + (size_t)row * DM) + F.lane + 64 * j);
        if (COMB) {
            const int d0 = tok[row * 8 + 6], d1 = tok[row * 8 + 7]; const float g0 = __int_as_float(tok[row * 8 + 4]), g1 = __int_as_float(tok[row * 8 + 5]);
#pragma unroll
            for (int j = 0; j < 4; ++j) {
                const v2u a = *((const v2u*)(Y + (size_t)d0 * DM) + F.lane + 64 * j), b = *((const v2u*)(Y + (size_t)d1 * DM) + F.lane + 64 * j);
                v[j].x = alpha * v[j].x + g0 * bflo(a.x) + g1 * bflo(b.x); v[j].y = alpha * v[j].y + g0 * bfhi(a.x) + g1 * bfhi(b.x);
                v[j].z = alpha * v[j].z + g0 * bflo(a.y) + g1 * bflo(b.y); v[j].w = alpha * v[j].w + g0 * bfhi(a.y) + g1 * bfhi(b.y);
            }
        }
        float s = 0.f;
#pragma unroll
        for (int j = 0; j < 4; ++j) s += (v[j].x + v[j].y) + (v[j].z + v[j].w);
        const float mean = wave_sum(s, F.lane) * (1.f / DM); float s2 = 0.f;
#pragma unroll
        for (int j = 0; j < 4; ++j) { v[j] = v[j] - mean; s2 += (v[j].x * v[j].x + v[j].y * v[j].y) + (v[j].z * v[j].z + v[j].w * v[j].w); }
        const float rstd = 1.f / sqrtf(wave_sum(s2, F.lane) * (1.f / DM) + LN_EPS);
#pragma unroll
        for (int j = 0; j < 4; ++j) {
            v[j] = v[j] * rstd * gv[j] + bv[j];
            *((f32x4*)(dst + (size_t)row * DM) + F.lane + 64 * j) = v[j];
            v2u w; w.x = pk2(v[j].x, v[j].y); w.y = pk2(v[j].z, v[j].w);
            *((v2u*)(XB + (size_t)row * DM) + F.lane + 64 * j) = w;
        }
        if (ROUTER) {
            float lg[8];
#pragma unroll
            for (int e = 0; e < 8; ++e) lg[e] = 0.f;
#pragma unroll
            for (int j = 0; j < 4; ++j)
#pragma unroll
                for (int i = 0; i < 4; ++i) {
                    const float xv = v[j][i];
                    const f32x4 w0 = rw[j][i][0], w1 = rw[j][i][1];
                    lg[0] += xv * w0.x; lg[1] += xv * w0.y; lg[2] += xv * w0.z; lg[3] += xv * w0.w;
                    lg[4] += xv * w1.x; lg[5] += xv * w1.y; lg[6] += xv * w1.z; lg[7] += xv * w1.w;
                }
#pragma unroll
            for (int e = 0; e < 8; ++e) lg[e] = wave_sum(lg[e], F.lane);
            int e0 = 0; float l0 = lg[0];
#pragma unroll
            for (int e = 1; e < 8; ++e) if (lg[e] > l0) { l0 = lg[e]; e0 = e; }
            int e1 = -1; float l1 = -INFINITY;
#pragma unroll
            for (int e = 0; e < 8; ++e) if (e != e0 && (e1 < 0 || lg[e] > l1)) { l1 = lg[e]; e1 = e; }
            const float ex = __expf(l1 - l0); const float g0 = 1.f / (1.f + ex), g1 = ex / (1.f + ex);
            if (F.lane == 0) {
                const unsigned r0 = __hip_atomic_fetch_add(lcnt + e0, 1u, __ATOMIC_RELAXED, __HIP_MEMORY_SCOPE_WORKGROUP), r1 = __hip_atomic_fetch_add(lcnt + e1, 1u, __ATOMIC_RELAXED, __HIP_MEMORY_SCOPE_WORKGROUP);
                int* t = tok + row * 8; t[0] = e0; t[1] = e1; t[2] = (int)r0; t[3] = (int)r1; t[4] = __float_as_int(g0); t[5] = __float_as_int(g1);
            }
        }
    }
    if (ROUTER) {
        __syncthreads();
        if (F.tid < 8) { const unsigned base = atomicAdd(cnt + F.tid, lcnt[F.tid]); blkbase[F.vcu * 8 + F.tid] = (int)base; }
    }
}

__device__ __forceinline__ void moe_layout(const Frame& F0, const unsigned* cnt) {
    const Frame F = refresh(F0);
    volatile LAS int* M = (volatile LAS int*)(F.lds + MISC_OFF);
    if (F.tid == 0) {
        int acc = 0;
#pragma unroll
        for (int e = 0; e < 8; ++e) { const unsigned c = __hip_atomic_load(cnt + e, RLX_AGENT); M[e] = acc * 256; acc += (int)((c + 255u) >> 8); M[8 + e] = acc; }
    }
    __syncthreads();
}
__device__ __forceinline__ void moe_gather(const Frame& F0, const bf16* XB, bf16* ROWS, int* tok, const int* blkbase) {
    const Frame F = refresh(F0);
    volatile LAS int* M = (volatile LAS int*)(F.lds + MISC_OFF);
    const int gw = F.vcu * NWAVES + F.wave, NGW = F.G * NWAVES;
    for (int t = gw; t < TT; t += NGW) {
        const int e0 = tok[t * 8 + 0], e1 = tok[t * 8 + 1], r0 = tok[t * 8 + 2], r1 = tok[t * 8 + 3];
        const int vb = ((t % NGW) >> 3) * 8;
        const int d0 = M[e0] + blkbase[vb + e0] + r0, d1 = M[e1] + blkbase[vb + e1] + r1;
        const v4u* s = (const v4u*)(XB + (size_t)t * DM) + F.lane; const v4u a = s[0], b = s[64];
        v4u* o0 = (v4u*)(ROWS + (size_t)d0 * DM) + F.lane; v4u* o1 = (v4u*)(ROWS + (size_t)d1 * DM) + F.lane;
        o0[0] = a; o0[64] = b; o1[0] = a; o1[64] = b;
        if (F.lane == 0) { tok[t * 8 + 6] = d0; tok[t * 8 + 7] = d1; }
    }
}

template <int G> __device__ __forceinline__ void pool_group(const Frame& F, const bf16* H, bf16* MIX) {
    constexpr int W = 2 << G;
    for (int idx = F.vcu * NTHR + F.tid; idx < TT * 8; idx += F.G * NTHR) {
        const int t = idx >> 3, c8 = idx & 7, ch = G * 64 + c8 * 8, pos = t & (SEQ - 1);
        const bf16* up = H + (size_t)t * INW + 1536 + ch;
        v4u v[W];
#pragma unroll
        for (int j = 0; j < W; ++j) { v[j] = (v4u){0u, 0u, 0u, 0u}; if (pos - j >= 0) v[j] = *(const v4u*)(up - (size_t)j * INW); }
        float s[8];
#pragma unroll
        for (int i = 0; i < 8; ++i) s[i] = 0.f;
#pragma unroll
        for (int j = 0; j < W; ++j) { s[0] += bflo(v[j].x); s[1] += bfhi(v[j].x); s[2] += bflo(v[j].y); s[3] += bfhi(v[j].y); s[4] += bflo(v[j].z); s[5] += bfhi(v[j].z); s[6] += bflo(v[j].w); s[7] += bfhi(v[j].w); }
        const int n = (pos + 1) < W ? (pos + 1) : W; const float inv = 1.f / (float)n;
        v4u o; o.x = pk2(s[0] * inv - bflo(v[0].x), s[1] * inv - bfhi(v[0].x)); o.y = pk2(s[2] * inv - bflo(v[0].y), s[3] * inv - bfhi(v[0].y));
        o.z = pk2(s[4] * inv - bflo(v[0].z), s[5] * inv - bfhi(v[0].z)); o.w = pk2(s[6] * inv - bflo(v[0].w), s[7] * inv - bfhi(v[0].w));
        *(v4u*)(MIX + (size_t)t * DM + 512 + ch) = o;
    }
}
__device__ __forceinline__ void pool_phase(const Frame& F0, const bf16* H, bf16* MIX) {
    const Frame F = refresh(F0);
    pool_group<0>(F, H, MIX); pool_group<1>(F, H, MIX); pool_group<2>(F, H, MIX); pool_group<3>(F, H, MIX);
}

__device__ __forceinline__ float sigmoid_f(float x) { return 1.f / (1.f + __expf(-x)); }
__device__ __forceinline__ float gelu_tanh(float x) { const float u = 0.7978845608028654f * (x + 0.044715f * x * x * x); const float t = 1.f - 2.f / (__expf(2.f * u) + 1.f); return 0.5f * x * (1.f + t); }
__device__ __forceinline__ void lru_phase(const Frame& F0, const Params& p, int l, const bf16* H, bf16* MIX, const float* XGS) {
    const Frame F = refresh(F0);
    constexpr int XCS = 68;
    LAS float* XC = (LAS float*)F.lds;
    LAS float* PB = (LAS float*)(F.lds + 69632);
    LAS float* AW = (LAS float*)(F.lds + 135168);
    LAS float* HW = (LAS float*)(F.lds + 135168 + 2048);
    LAS float* CIN = (LAS float*)(F.lds + 135168 + 4096);
    unsigned* flags = (unsigned*)(p.ws + WS_CTL) + CW_FLAG; float* agg = (float*)(p.ws + WS_AGG);
    const float* convw = p.in[I_CONVW] + (size_t)l * 4 * 256; const float* convb = p.in[I_CONVB] + (size_t)l * 256;
    for (int unit = F.vcu; unit < 256; unit += F.G) {
        const int seg = unit >> 5, bc = unit & 31, b = bc >> 2, cb = bc & 3;
        const size_t row0 = (size_t)b * SEQ + seg * 256;
        const int d = F.lane, chd = cb * 64 + d;
        __syncthreads();
        {
            const int c8 = F.tid & 7, ch = cb * 64 + c8 * 8;
            float cw[4][8], cbv[8];
#pragma unroll
            for (int i = 0; i < 8; ++i) { cbv[i] = convb[ch + i];
#pragma unroll
                for (int j = 0; j < 4; ++j) cw[j][i] = convw[j * 256 + ch + i]; }
#pragma unroll
            for (int it = 0; it < 4; ++it) {
                const int t = (F.tid >> 3) + 64 * it; const int pos = seg * 256 + t;
                float a[8];
#pragma unroll
                for (int i = 0; i < 8; ++i) a[i] = cbv[i];
#pragma unroll
                for (int j = 0; j < 4; ++j) {
                    if (pos - 3 + j >= 0) {
                        const v4u v = *(const v4u*)(H + (row0 + t - 3 + j) * INW + 1792 + ch);
                        a[0] += bflo(v.x) * cw[j][0]; a[1] += bfhi(v.x) * cw[j][1]; a[2] += bflo(v.y) * cw[j][2]; a[3] += bfhi(v.y) * cw[j][3];
                        a[4] += bflo(v.z) * cw[j][4]; a[5] += bfhi(v.z) * cw[j][5]; a[6] += bflo(v.w) * cw[j][6]; a[7] += bfhi(v.w) * cw[j][7];
                    }
                }
                LAS f32x4* o = (LAS f32x4*)(XC + t * XCS + c8 * 8);
                o[0] = (f32x4){a[0], a[1], a[2], a[3]}; o[1] = (f32x4){a[4], a[5], a[6], a[7]};
            }
        }
        __syncthreads();
        {
            const int col = F.lane & 31, hi = F.lane >> 5;
            const float* wa = p.in[I_WA] + (size_t)(l * 4 + cb) * 4096; const float* wi = p.in[I_WI] + (size_t)(l * 4 + cb) * 4096;
            bf16x8 fa[4], wfa[4][2], wfi[4][2];
#pragma unroll
            for (int ks = 0; ks < 4; ++ks)
#pragma unroll
                for (int hf = 0; hf < 2; ++hf) {
                    const float* sa = wa + (16 * ks + 8 * hi) * 64 + 32 * hf + col; const float* si = wi + (16 * ks + 8 * hi) * 64 + 32 * hf + col;
                    v4u w; w.x = pk2(sa[0], sa[64]); w.y = pk2(sa[128], sa[192]); w.z = pk2(sa[256], sa[320]); w.w = pk2(sa[384], sa[448]); wfa[ks][hf] = __builtin_bit_cast(bf16x8, w);
                    v4u u; u.x = pk2(si[0], si[64]); u.y = pk2(si[128], si[192]); u.z = pk2(si[256], si[320]); u.w = pk2(si[384], si[448]); wfi[ks][hf] = __builtin_bit_cast(bf16x8, u);
                }
            const LAS float* xr = XC + (32 * F.wave + col) * XCS + 8 * hi;
#pragma unroll
            for (int ks = 0; ks < 4; ++ks) { const f32x4 x0 = *(const LAS f32x4*)(xr + 16 * ks), x1 = *(const LAS f32x4*)(xr + 16 * ks + 4);
                v4u w; w.x = pk2(x0.x, x0.y); w.y = pk2(x0.z, x0.w); w.z = pk2(x1.x, x1.y); w.w = pk2(x1.z, x1.w); fa[ks] = __builtin_bit_cast(bf16x8, w); }
            f32x16 ra[2], ia[2];
#pragma unroll
            for (int hf = 0; hf < 2; ++hf)
#pragma unroll
                for (int r = 0; r < 16; ++r) { ra[hf][r] = 0.f; ia[hf][r] = 0.f; }
#pragma unroll
            for (int ks = 0; ks < 4; ++ks)
#pragma unroll
                for (int hf = 0; hf < 2; ++hf) {
                    ra[hf] = __builtin_amdgcn_mfma_f32_32x32x16_bf16(fa[ks], wfa[ks][hf], ra[hf], 0, 0, 0);
                    ia[hf] = __builtin_amdgcn_mfma_f32_32x32x16_bf16(fa[ks], wfi[ks][hf], ia[hf], 0, 0, 0);
                }
#pragma unroll
            for (int hf = 0; hf < 2; ++hf) {
                const int ch = cb * 64 + 32 * hf + col;
                const float ba = p.in[I_BA][l * 256 + ch], bi = p.in[I_BI][l * 256 + ch], lam = p.in[I_LLAM][l * 256 + ch];
                const float sp8 = -8.0f * log1pf(expf(-lam));
#pragma unroll
                for (int r = 0; r < 16; ++r) {
                    const int tk = 32 * F.wave + (r & 3) + 8 * (r >> 2) + 4 * hi;
                    const float xcd = XC[tk * XCS + 32 * hf + col];
                    const float rr = sigmoid_f(ra[hf][r] + ba), ii = sigmoid_f(ia[hf][r] + bi);
                    const float a = __expf(rr * sp8);
                    const float bt = sqrtf(fmaxf(1.0f - a * a, 0.f)) * (ii * xcd);
                    PB[tk * 64 + 32 * hf + col] = a; XC[tk * XCS + 32 * hf + col] = bt;
                }
            }
        }
        {
            float h = 0.f, P = 1.f;
#pragma unroll 8
            for (int tt = 0; tt < 32; ++tt) {
                const int t = F.wave * 32 + tt;
                const float a = PB[t * 64 + d], bt = XC[t * XCS + d];
                h = a * h + bt; P = a * P;
                XC[t * XCS + d] = h; PB[t * 64 + d] = P;
            }
            AW[F.wave * 64 + d] = P; HW[F.wave * 64 + d] = h;
        }
        __syncthreads();
        float Apre = 1.f, Hpre = 0.f, Ablk = 1.f, Hblk = 0.f;
#pragma unroll
        for (int v = 0; v < 8; ++v) { const float a = AW[v * 64 + d], hh = HW[v * 64 + d];
            if (v < F.wave) { Hpre = a * Hpre + hh; Apre = a * Apre; }
            Hblk = a * Hblk + hh; Ablk = a * Ablk; }
        if (F.wave == 0) {
            if (seg < 7) {
                __hip_atomic_store(agg + (size_t)unit * 128 + d, Ablk, RLX_AGENT); __hip_atomic_store(agg + (size_t)unit * 128 + 64 + d, Hblk, RLX_AGENT);
                asm volatile("s_waitcnt vmcnt(0)" ::: "memory");
                if (F.lane == 0) __hip_atomic_store(flags + unit, (unsigned)(l + 1), __ATOMIC_RELEASE, __HIP_MEMORY_SCOPE_AGENT);
            }
            if (seg > 0) {
                unsigned spins = 0;
                for (;;) {
                    const unsigned f = (F.lane < seg) ? __hip_atomic_load(flags + F.lane * 32 + bc, RLX_AGENT) : (unsigned)(l + 1);
                    if (__all(f >= (unsigned)(l + 1))) break;
                    __builtin_amdgcn_s_sleep(2); if (++spins > (1u << 22)) break;
                }
                __builtin_amdgcn_fence(__ATOMIC_ACQUIRE, "agent");
            }
            float pa[7], ph[7];
#pragma unroll
            for (int s = 0; s < 7; ++s) { pa[s] = 1.f; ph[s] = 0.f;
                if (s < seg) { pa[s] = __hip_atomic_load(agg + (size_t)(s * 32 + bc) * 128 + d, RLX_AGENT); ph[s] = __hip_atomic_load(agg + (size_t)(s * 32 + bc) * 128 + 64 + d, RLX_AGENT); } }
            float cin = 0.f;
#pragma unroll
            for (int s = 0; s < 7; ++s) cin = pa[s] * cin + ph[s];
            CIN[d] = cin;
        }
        __syncthreads();
        {
            const float cw = Apre * CIN[d] + Hpre;
            const float* xs0 = XGS + (row0 + F.wave * 32) * 256 + chd;
#pragma unroll 1
            for (int c = 0; c < 4; ++c) {
                float xg[8];
#pragma unroll
                for (int k = 0; k < 8; ++k) { const float* xs = xs0 + (c * 8 + k) * 256;
                    xg[k] = (xs[0] + xs[(size_t)TT * 256]) + (xs[(size_t)2 * TT * 256] + xs[(size_t)3 * TT * 256]); }
#pragma unroll
                for (int k = 0; k < 8; ++k) {
                    const int t = F.wave * 32 + c * 8 + k;
                    const float hf = XC[t * XCS + d] + PB[t * 64 + d] * cw;
                    MIX[(row0 + t) * DM + 768 + chd] = (bf16)(pk2(hf * gelu_tanh(xg[k]), 0.f) & 0xffffu);
                }
            }
        }
    }
    __syncthreads();
}

constexpr int AK_STRIDE = 272, AV_STRIDE = 320, AK_BYTES = 64 * AK_STRIDE, AV_BYTES = 64 * AV_STRIDE, AOB_OFF = 40960;
constexpr float ATT_C = 0.125f * 1.4426950408889634f;
__device__ __forceinline__ s16x4 vtr(const LAS unsigned char* p) { typedef short v4i16_t __attribute__((ext_vector_type(4)));
    return __builtin_bit_cast(s16x4, __builtin_amdgcn_ds_read_tr16_b64_v4i16((LAS v4i16_t*)p)); }
__device__ __forceinline__ void attn_block(const Frame& F, const bf16* H, bf16* MIX, int b, int h, int qb, float lam, float omli, const float* subg) {
    const int tid = F.tid, lane = F.lane, wid = F.wave, m = wid >> 2, rg = wid & 3, ql = lane & 31, hi = lane >> 5;
    const int q0 = qb * 128; const size_t rowb = (size_t)b * SEQ;
    bf16x8 qr[4];
    { const bf16* qp = H + (rowb + q0 + 32 * rg + ql) * INW + h * 128 + m * 64 + 8 * hi;
#pragma unroll
      for (int d0 = 0; d0 < 4; ++d0) qr[d0] = *(const bf16x8*)(qp + 16 * d0); }
    const int NT = q0 / 64 + 2, nkv = (q0 + 32 * rg) / 64 + 1;
    f32x16 o[4];
#pragma unroll
    for (int i = 0; i < 4; ++i)
#pragma unroll
        for (int r = 0; r < 16; ++r) o[i][r] = 0.f;
    float mrun = -INFINITY, lrun = 0.f;
    const int lr = tid >> 4, lc = tid & 15;
    const bf16* kg = H + (rowb + lr) * INW + 512 + h * 128 + lc * 8;
    const bf16* vg = H + (rowb + lr) * INW + 1024 + h * 128 + lc * 8;
    LAS unsigned char* kd = F.lds + lr * AK_STRIDE + lc * 16; LAS unsigned char* vd = F.lds + AK_BYTES + lr * AV_STRIDE + lc * 16;
    v4u rk0, rk1, rv0, rv1;
    rk0 = *(const v4u*)kg; rk1 = *(const v4u*)(kg + (size_t)32 * INW); rv0 = *(const v4u*)vg; rv1 = *(const v4u*)(vg + (size_t)32 * INW);
    const LAS unsigned char* kb = F.lds + ql * AK_STRIDE + (m * 64 + 8 * hi) * 2;
    const LAS unsigned char* vb = F.lds + AK_BYTES + (4 * hi + ((lane >> 2) & 3)) * AV_STRIDE + (16 * ((lane >> 4) & 1) + 4 * (lane & 3)) * 2;
    for (int t = 0; t < NT; ++t) {
        __syncthreads();
        *(LAS v4u*)kd = rk0; *(LAS v4u*)(kd + 32 * AK_STRIDE) = rk1; *(LAS v4u*)vd = rv0; *(LAS v4u*)(vd + 32 * AV_STRIDE) = rv1;
        __syncthreads();
        if (t + 1 < NT) { const size_t off = (size_t)(t + 1) * 64 * INW;
            rk0 = *(const v4u*)(kg + off); rk1 = *(const v4u*)(kg + off + (size_t)32 * INW); rv0 = *(const v4u*)(vg + off); rv1 = *(const v4u*)(vg + off + (size_t)32 * INW); }
        if (t < nkv) {
            f32x16 p0, p1;
#pragma unroll
            for (int r = 0; r < 16; ++r) { p0[r] = 0.f; p1[r] = 0.f; }
#pragma unroll
            for (int d0 = 0; d0 < 4; ++d0) {
                const bf16x8 a0 = *(const LAS bf16x8*)(kb + d0 * 32), a1 = *(const LAS bf16x8*)(kb + 32 * AK_STRIDE + d0 * 32);
                p0 = __builtin_amdgcn_mfma_f32_32x32x16_bf16(a0, qr[d0], p0, 0, 0, 0);
                p1 = __builtin_amdgcn_mfma_f32_32x32x16_bf16(a1, qr[d0], p1, 0, 0, 0);
            }
            float mx = p0[0];
#pragma unroll
            for (int r = 0; r < 16; ++r) { mx = fmaxf(mx, p0[r]); mx = fmaxf(mx, p1[r]); }
            mx = fmaxf(mx, shfl_xor_l(mx, 32, lane));
            const float mnew = fmaxf(mrun, mx * ATT_C);
            const float al = __builtin_amdgcn_exp2f(mrun - mnew);
            float sum = 0.f;
#pragma unroll
            for (int r = 0; r < 16; ++r) { p0[r] = __builtin_amdgcn_exp2f(p0[r] * ATT_C - mnew); p1[r] = __builtin_amdgcn_exp2f(p1[r] * ATT_C - mnew); sum += p0[r] + p1[r]; }
            lrun = lrun * al + sum; mrun = mnew;
#pragma unroll
            for (int i = 0; i < 4; ++i)
#pragma unroll
                for (int r = 0; r < 16; ++r) o[i][r] *= al;
            bf16x8 pb[4];
#pragma unroll
            for (int j = 0; j < 4; ++j) {
                v4u w;
                if (j < 2) { w.x = pk2(p0[8 * j + 0], p0[8 * j + 1]); w.y = pk2(p0[8 * j + 2], p0[8 * j + 3]); w.z = pk2(p0[8 * j + 4], p0[8 * j + 5]); w.w = pk2(p0[8 * j + 6], p0[8 * j + 7]); }
                else { const int jj = j - 2; w.x = pk2(p1[8 * jj + 0], p1[8 * jj + 1]); w.y = pk2(p1[8 * jj + 2], p1[8 * jj + 3]); w.z = pk2(p1[8 * jj + 4], p1[8 * jj + 5]); w.w = pk2(p1[8 * jj + 6], p1[8 * jj + 7]); }
                pb[j] = __builtin_bit_cast(bf16x8, w);
            }
#pragma unroll
            for (int j = 0; j < 4; ++j)
#pragma unroll
                for (int db = 0; db < 4; ++db) {
                    const s16x4 lo = vtr(vb + j * 16 * AV_STRIDE + db * 64), hi4 = vtr(vb + j * 16 * AV_STRIDE + 8 * AV_STRIDE + db * 64);
                    const bf16x8 a = (bf16x8){lo[0], lo[1], lo[2], lo[3], hi4[0], hi4[1], hi4[2], hi4[3]};
                    o[db] = __builtin_amdgcn_mfma_f32_32x32x16_bf16(a, pb[j], o[db], 0, 0, 0);
                }
        }
    }
    lrun += shfl_xor_l(lrun, 32, lane);
    const float inv = 1.f / lrun;
    LAS float* ob = (LAS float*)(F.lds + AOB_OFF) + rg * 4096;
    if (m == 1) {
#pragma unroll
        for (int i = 0; i < 4; ++i)
#pragma unroll
            for (int r = 0; r < 16; ++r) ob[(i * 16 + r) * 64 + lane] = o[i][r] * inv;
    }
    __syncthreads();
    if (m == 0) {
        float ss = 0.f;
#pragma unroll
        for (int i = 0; i < 4; ++i)
#pragma unroll
            for (int r = 0; r < 16; ++r) { const float v = o[i][r] * inv - lam * ob[(i * 16 + r) * 64 + lane]; o[i][r] = v; ss += v * v; }
        ss += shfl_xor_l(ss, 32, lane);
        const float rinv = 1.0f / sqrtf(ss * (1.f / 128.f) + 1e-5f) * omli;
        bf16* op = MIX + (rowb + q0 + 32 * rg + ql) * DM + h * 128 + 4 * hi;
#pragma unroll
        for (int i = 0; i < 4; ++i)
#pragma unroll
            for (int rq = 0; rq < 4; ++rq) {
                const int dd = i * 32 + 8 * rq + 4 * hi; const f32x4 g = *(const f32x4*)(subg + dd);
                v2u w; w.x = pk2(o[i][4 * rq] * rinv * g.x, o[i][4 * rq + 1] * rinv * g.y); w.y = pk2(o[i][4 * rq + 2] * rinv * g.z, o[i][4 * rq + 3] * rinv * g.w);
                *(v2u*)(op + i * 32 + 8 * rq) = w;
            }
    }
}
__device__ __forceinline__ void attn_phase(const Frame& F0, const Params& p, int l, const bf16* H, bf16* MIX) {
    const Frame F = refresh(F0);
    const float* lv = p.in[I_ALAM] + (size_t)l * 256; const float* subg = p.in[I_ASUB] + (size_t)l * 128;
    const float linit = 0.8f - 0.6f * expf(-0.3f * (float)l);
    const float s01 = wave_sum(lv[F.lane] * lv[64 + F.lane], F.lane), s23 = wave_sum(lv[128 + F.lane] * lv[192 + F.lane], F.lane);
    const float lam = expf(s01) - expf(s23) + linit;
    for (int u = F.vcu; u < 256; u += F.G) {
        const int bh = u >> 3, s = u & 7, b = bh >> 2, h = bh & 3;
        attn_block(F, H, MIX, b, h, 15 - s, lam, 1.f - linit, subg);
        attn_block(F, H, MIX, b, h, s, lam, 1.f - linit, subg);
    }
    __syncthreads();
}

#define XB_TMO      128
#define XB_XCNT(j)  (256  + 64 * (j))
#define XB_XSUB(j)  (1280 + 64 * (j))
#define XB_XGEN(j)  (2304 + 64 * (j))
#define XB_TOP      3328
#define XB_TOPGEN   3392
#define XCD_BAR_WORDS 3456
#define XB_SPIN_CAP (1u << 18)

__device__ __forceinline__ unsigned xb_ld(unsigned* p)              { return __hip_atomic_load(p, __ATOMIC_RELAXED, __HIP_MEMORY_SCOPE_AGENT); }
__device__ __forceinline__ unsigned xb_add(unsigned* p, unsigned v) { return __hip_atomic_fetch_add(p, v, __ATOMIC_RELAXED, __HIP_MEMORY_SCOPE_AGENT); }
__device__ __forceinline__ unsigned xb_xcc_id() { return (unsigned)__builtin_amdgcn_s_getreg((3 << 11) | 20) & 0xFu; }
#define XB_SPIN(cond, bar) do { unsigned _sp = 0; while (cond) { __builtin_amdgcn_s_sleep(1); \
    if ((++_sp & 255u) == 0u) { if (xb_ld(&(bar)[XB_TMO])) break; if (_sp > XB_SPIN_CAP) { atomicAdd(&(bar)[XB_TMO], 1u); break; } } } } while (0)

struct XcdBarrier {
    unsigned* bar; unsigned x;
    volatile LAS unsigned* st;
};

__device__ __forceinline__ XcdBarrier xcd_barrier_post(unsigned* bar, volatile LAS unsigned* st) {
    XcdBarrier b; b.bar = bar; b.x = xb_xcc_id(); b.st = st;
    if (threadIdx.x == 0) (void)xb_add(&bar[XB_XCNT(b.x)], 1u);
    return b;
}
__device__ __forceinline__ void xcd_barrier_complete(unsigned* bar, unsigned x, unsigned& nloc, unsigned& nx) {
    const unsigned G = gridDim.x * gridDim.y * gridDim.z;
    unsigned sum, cnt, mine, sp = 0u;
    for (;;) {
        sum = 0u; cnt = 0u; mine = 0u;
#pragma unroll
        for (unsigned j = 0; j < 16; ++j) { const unsigned c = xb_ld(&bar[XB_XCNT(j)]); sum += c; cnt += (c > 0u) ? 1u : 0u; mine = (j == x) ? c : mine; }
        if (sum == G) break;
        __builtin_amdgcn_s_sleep(1);
        if ((++sp & 255u) == 0u) { if (xb_ld(&bar[XB_TMO])) break; if (sp > XB_SPIN_CAP) { atomicAdd(&bar[XB_TMO], 1u); break; } }
    }
    nloc = mine > 0u ? mine : 1u; nx = cnt > 0u ? cnt : 1u;
}

__device__ __forceinline__ void xcd_barrier(const XcdBarrier& b) {
    asm volatile("s_waitcnt vmcnt(0)" ::: "memory");
    __syncthreads();
    if (threadIdx.x == 0) {
        unsigned* bar = b.bar;
        __builtin_amdgcn_s_waitcnt(0);
        unsigned nloc = b.st[0], nx = b.st[1];
        if (nloc == 0u) { xcd_barrier_complete(bar, b.x, nloc, nx); b.st[0] = nloc; b.st[1] = nx; }
        const unsigned old = xb_add(&bar[XB_XSUB(b.x)], 1u);
        const unsigned gen = old / nloc;
        if (old + 1u == (gen + 1u) * nloc) {
            __builtin_amdgcn_fence(__ATOMIC_RELEASE, "agent");
            asm volatile("s_waitcnt vmcnt(0)" ::: "memory");
            const unsigned og = xb_add(&bar[XB_TOP], 1u);
            const unsigned tg = og / nx;
            if (og + 1u == (tg + 1u) * nx) xb_add(&bar[XB_TOPGEN], 1u);
            else XB_SPIN(xb_ld(&bar[XB_TOPGEN]) == tg, bar);
            __builtin_amdgcn_fence(__ATOMIC_ACQUIRE, "agent");
            xb_add(&bar[XB_XGEN(b.x)], 1u);
            asm volatile("s_waitcnt vmcnt(0)" ::: "memory");
        } else {
            XB_SPIN(xb_ld(&bar[XB_XGEN(b.x)]) == gen, bar);
            __builtin_amdgcn_fence(__ATOMIC_ACQUIRE, "agent");
            asm volatile("s_waitcnt vmcnt(0)" ::: "memory");
        }
    }
    __syncthreads();
}

typedef const __attribute__((address_space(4))) Params* kparams_ptr_t;
__device__ __forceinline__ const Params& kparams() { kparams_ptr_t kp = (kparams_ptr_t)__builtin_amdgcn_kernarg_segment_ptr(); asm volatile("" : "+s"(kp)); return *(const Params*)kp; }
#define WS_(T, off) ((T*)(kparams().ws + (off)))
#define P_X WS_(float, WS_X)
#define P_XB WS_(bf16, WS_XB)
#define P_H WS_(bf16, WS_H)
#define P_MIX WS_(bf16, WS_MIX)
#define P_HID WS_(bf16, WS_HID)
#define P_ROWS WS_(bf16, WS_ROWS)
#define P_Y WS_(bf16, WS_ROWS)
#define P_tok WS_(int, WS_TOK)
#define P_blkbase WS_(int, WS_AGG + 256 * 1024)
#define P_SLAB WS_(float, WS_SLAB)
#define P_WIN WS_(bf16, WS_WIN)
#define P_WOUT WS_(bf16, WS_WOUT)
#define P_WGU WS_(bf16, WS_WGU)
#define P_WD WS_(bf16, WS_WD)
#define P_ctl WS_(unsigned, WS_CTL)
namespace pg8 {
struct EpiResid {
    static constexpr bool PERM = false, AFTER_DRAIN = false;
    int first; float alpha;
    __device__ __forceinline__ void operator()(const f32x4 (&acc)[2][2][4][2], const Unit& u, int wr, int wc, int fr, int fq) const {
        const float* base = first ? kparams().in[I_X] : (const float*)WS_(float, WS_X); float* out = WS_(float, WS_X); constexpr int ldc = DM;
        const int row0 = u.pm * BM + wr * 64 + fr; const int col0 = u.pn * BM + wc * 32 + 4 * fq;
#pragma unroll
        for (int ai = 0; ai < 2; ++ai)
#pragma unroll
            for (int m = 0; m < 4; ++m) { const size_t off = (size_t)(row0 + ai * HALF + m * 16) * ldc + col0;
#pragma unroll
                for (int bj = 0; bj < 2; ++bj)
#pragma unroll
                    for (int n = 0; n < 2; ++n) { const f32x4 bs = *(const f32x4*)(base + off + bj * HALF + n * 16);
                        *(f32x4*)(out + off + bj * HALF + n * 16) = bs * alpha + acc[ai][bj][m][n]; }
                asm volatile("" ::: "memory"); }
    }
};
}
__global__ void __launch_bounds__(NTHR, 2) mega_fwd(Params p_unused) {
    extern __shared__ __attribute__((aligned(16))) unsigned char lds_raw[];
    cg::grid_group grid = cg::this_grid();
    Frame F;
    F.lds = (LAS unsigned char*)lds_raw;
    F.tid = threadIdx.x; F.lane = F.tid & 63; F.wave = __builtin_amdgcn_readfirstlane(F.tid >> 6);
    F.G = gridDim.x; { const int bx = blockIdx.x; F.vcu = (F.G % 8 == 0) ? (bx % 8) * (F.G / 8) + bx / 8 : bx; }
    const float alpha = 1.6817928305074290f;
    const int bx = (int)blockIdx.x;
    if (F.tid < 64) ((LAS unsigned*)(F.lds + MISC_OFF))[F.tid] = 0u;
    __syncthreads();
    (void)xcd_barrier_post(P_ctl + CW_BAR, (volatile LAS unsigned*)(F.lds + MISC_OFF) + 32);
#define GRID_BAR() do { XcdBarrier b_; b_.bar = P_ctl + CW_BAR; b_.x = xb_xcc_id(); b_.st = (volatile LAS unsigned*)(F.lds + MISC_OFF) + 32; xcd_barrier(b_); } while (0)

#ifndef NO_PREP
    prep_layer(F, kparams(), 0);
#ifdef PROBE_PREP
    prep_layer(F, kparams(), 1); prep_layer(F, kparams(), 2); prep_layer(F, kparams(), 3); prep_layer(F, kparams(), 0);
#endif
#endif
    grid.sync();
#ifdef PROBE_SYNC
    for (int i = 0; i < 32; ++i) GRID_BAR();
#endif
#pragma unroll 1
    for (int l = 0; l < DEPTH; ++l) {
        const bool moe = (l & 1);
        { pg8::Gemm g{P_XB, P_WIN, TT, 2048, DM, DM}; pg8::StaticOrder S; S.init(TT, 2048, fresh_s(F.G), fresh_s(bx));
          pg8::EpiStore E{P_H, INW, INW / 256};
          pg8::gemm_phase<pg8::EpiStore, pg8::StaticOrder, true, true>(F.lds, g, S, E);
        }
        { pg8::Gemm g{P_XB, P_WIN, TT, 256, 256, DM}; pg8::TailOrder S{TT / 256, 4, 256, fresh_s(F.G), fresh_s(bx), 0, 1, 8, 0, 0, 0, 0, 0, 0, 0, 0, 0};
          pg8::EpiSlab E{P_SLAB, (size_t)TT * 256, 256, 0, 8, 1, 256};
          pg8::gemm_phase<pg8::EpiSlab, pg8::TailOrder, true, true>(F.lds, g, S, E);
        }
        GRID_BAR();
#ifndef NO_LRU
        lru_phase(F, kparams(), l, P_H, P_MIX, P_SLAB);
#ifdef PROBE_LRU
        lru_phase(F, kparams(), l, P_H, P_MIX, P_SLAB); pool_phase(F, P_H, P_MIX);
#endif
#endif
#ifndef NO_POOL
        pool_phase(F, P_H, P_MIX);
#endif
#ifndef NO_ATTN
        attn_phase(F, kparams(), l, P_H, P_MIX);
#ifdef PROBE_ATTN
        attn_phase(F, kparams(), l, P_H, P_MIX);
#endif
#endif
        GRID_BAR();
        { pg8::Gemm g{P_MIX, P_WOUT, TT, DM, DM, DM}; pg8::StaticOrder S; S.init(TT, DM, fresh_s(F.G), fresh_s(bx));
          pg8::EpiResid E{l == 0 ? 1 : 0, alpha};
#ifndef NO_G2
          pg8::gemm_phase<pg8::EpiResid, pg8::StaticOrder, false, true>(F.lds, g, S, E);
#endif
        }
        GRID_BAR();
        unsigned* cnt = P_ctl + CW_CNT + 64 * (l >> 1);
#ifndef NO_LN
        if (moe) ln_phase<false, true>(F, P_X, P_X, P_XB, kparams().in[I_LN1G] + l * DM, kparams().in[I_LN1B] + l * DM, alpha, nullptr, P_tok, kparams().in[I_ROUT] + (size_t)(l >> 1) * DM * 8, cnt, P_blkbase);
        else ln_phase<false, false>(F, P_X, P_X, P_XB, kparams().in[I_LN1G] + l * DM, kparams().in[I_LN1B] + l * DM, alpha, nullptr, nullptr, nullptr, nullptr, nullptr);
#endif
#ifdef PROBE_LN
        ln_phase<false, false>(F, P_X, (float*)P_HID, (bf16*)((unsigned char*)P_HID + 64 * MiB), kparams().in[I_LN1G] + l * DM, kparams().in[I_LN1B] + l * DM, alpha, nullptr, nullptr, nullptr, nullptr, nullptr);
        ln_phase<false, false>(F, P_X, (float*)P_HID, (bf16*)((unsigned char*)P_HID + 64 * MiB), kparams().in[I_LN1G] + l * DM, kparams().in[I_LN1B] + l * DM, alpha, nullptr, nullptr, nullptr, nullptr, nullptr);
#endif
        GRID_BAR();
        float* dst = (l == DEPTH - 1) ? kparams().out : P_X;
        if (!moe) {
            { pg8::Gemm g{P_XB, P_WGU, TT, 2 * FF, DM, DM}; pg8::StaticOrder S; S.init(TT, 2 * FF, fresh_s(F.G), fresh_s(bx));
              pg8::EpiSwiglu E{P_HID, FF, 2 * FF / 256};
#ifndef NO_G3
              pg8::gemm_phase<pg8::EpiSwiglu, pg8::StaticOrder, true, true>(F.lds, g, S, E);
#endif
#ifdef PROBE_G3
              pg8::gemm_phase<pg8::EpiSwiglu, pg8::StaticOrder, true, true>(F.lds, g, S, E);
#endif
        }
            GRID_BAR();
            { pg8::Gemm g{P_HID, P_WD, TT, DM, FF, FF}; pg8::StaticOrder S; S.init(TT, DM, fresh_s(F.G), fresh_s(bx));
              pg8::EpiResid E{0, alpha};
#ifndef NO_G4
              pg8::gemm_phase<pg8::EpiResid, pg8::StaticOrder, false, true>(F.lds, g, S, E);
#endif
        }
            GRID_BAR();
#ifndef NO_LN
            ln_phase<false, false>(F, P_X, dst, P_XB, kparams().in[I_LN2G] + l * DM, kparams().in[I_LN2B] + l * DM, alpha, nullptr, nullptr, nullptr, nullptr, nullptr);
#endif
        } else {
            moe_layout(F, cnt);
#ifndef NO_GATHER
            moe_gather(F, P_XB, P_ROWS, P_tok, P_blkbase);
#endif
            volatile LAS int* M = (volatile LAS int*)(F.lds + MISC_OFF);
            const int pe0 = M[8], pe1 = M[9], pe2 = M[10], pe3 = M[11], pe4 = M[12], pe5 = M[13], pe6 = M[14], pe7 = M[15];
            GRID_BAR();
            { pg8::Gemm g{P_ROWS, P_WGU, MOE_MAXBLK * 256, 2 * FF, DM, DM}; pg8::MoeOrder S; S.so.init(pe7 * 256, 2 * FF, fresh_s(F.G), fresh_s(bx)); S.nN = 2 * FF / 256; S.pe0 = pe0; S.pe1 = pe1; S.pe2 = pe2; S.pe3 = pe3; S.pe4 = pe4; S.pe5 = pe5; S.pe6 = pe6; S.pe7 = pe7;
              pg8::EpiSwiglu E{P_HID, FF, 2 * FF / 256};
#ifndef NO_G5
              pg8::gemm_phase<pg8::EpiSwiglu, pg8::MoeOrder, true, true>(F.lds, g, S, E);
#endif
#ifdef PROBE_MOE
              pg8::gemm_phase<pg8::EpiSwiglu, pg8::MoeOrder, true, true>(F.lds, g, S, E);
#endif
        }
            GRID_BAR();
            { pg8::Gemm g{P_HID, P_WD, MOE_MAXBLK * 256, DM, FF, FF}; pg8::MoeOrder S; S.so.init(pe7 * 256, DM, fresh_s(F.G), fresh_s(bx)); S.nN = DM / 256; S.pe0 = pe0; S.pe1 = pe1; S.pe2 = pe2; S.pe3 = pe3; S.pe4 = pe4; S.pe5 = pe5; S.pe6 = pe6; S.pe7 = pe7;
              pg8::EpiStore E{P_Y, DM, DM / 256};
#ifndef NO_G6
              pg8::gemm_phase<pg8::EpiStore, pg8::MoeOrder, true, true>(F.lds, g, S, E);
#endif
#ifdef PROBE_MOE
              pg8::gemm_phase<pg8::EpiStore, pg8::MoeOrder, true, true>(F.lds, g, S, E);
#endif
        }
            GRID_BAR();
#ifndef NO_LN
            ln_phase<true, false>(F, P_X, dst, P_XB, kparams().in[I_LN2G] + l * DM, kparams().in[I_LN2B] + l * DM, alpha, P_Y, P_tok, nullptr, nullptr, nullptr);
#endif
        }
#ifndef NO_PREP
        if (l + 1 < DEPTH) { prep_layer(F, kparams(), l + 1); GRID_BAR(); }
#endif
    }
}

extern "C" void kernel_launch(void* const* d_in, const int* in_sizes, int n_in, void* d_out, int out_size, void* d_ws, size_t ws_size, hipStream_t stream) {
    static int grid = 0;
    if (grid == 0) {
        if (n_in != 25 || ws_size < WS_END) { fprintf(stderr, "kernel_launch: unexpected n_in %d / ws %zu\n", n_in, ws_size); grid = -1; return; }
        int dev = 0, cus = 0, per_cu = 0;
        hipGetDevice(&dev); hipDeviceGetAttribute(&cus, hipDeviceAttributeMultiprocessorCount, dev);
        hipFuncSetAttribute((const void*)mega_fwd, hipFuncAttributeMaxDynamicSharedMemorySize, LDS_BYTES);
        hipOccupancyMaxActiveBlocksPerMultiprocessor(&per_cu, (const void*)mega_fwd, NTHR, LDS_BYTES);
        if (per_cu < 1) { fprintf(stderr, "kernel_launch: occupancy query says %d blocks per CU\n", per_cu); per_cu = 1; }
        grid = cus * 1;
        (void)hipGetLastError();
    }
    if (grid < 0) return;
    hipMemsetAsync((char*)d_ws + WS_CTL, 0, CTL_BYTES, stream);
    Params p{};
    for (int i = 0; i < 25; ++i) p.in[i] = (const float*)d_in[i];
    p.out = (float*)d_out; p.ws = (unsigned char*)d_ws; p.pad0 = 0; p.pad1 = 0;
    void* args[] = {&p};
    hipError_t e = hipLaunchCooperativeKernel((const void*)mega_fwd, dim3(grid), dim3(NTHR), args, LDS_BYTES, stream);
    if (e != hipSuccess) fprintf(stderr, "cooperative launch failed: %s (grid %d)\n", hipGetErrorString(e), grid);
}
```

```cpp
#include <hip/hip_runtime.h>
#include <hip/hip_cooperative_groups.h>
#include <cstdio>
#include <cstdint>
#include <cmath>
namespace cg = cooperative_groups;
namespace pg8 {
#define PG8_LAS __attribute__((address_space(3)))
typedef unsigned short bf16_t;
typedef short bf16x8 __attribute__((ext_vector_type(8)));
typedef float f32x4 __attribute__((ext_vector_type(4)));
typedef unsigned u32x4 __attribute__((ext_vector_type(4)));
constexpr int BM = 256, BK = 64, HALF = 128, HTB = HALF * BK * 2  , STAGE_BYTES = 8 * HTB, NXCD = 8, WGM = 8;

__host__ __device__ __forceinline__ int lds_byte(int r, int c) { const int st = (r >> 4) * 2 + (c >> 5), rr = r & 15, cc = c & 31, ob = rr * 64 + cc * 2; return st * 1024 + (ob ^ (((ob >> 9) & 1) << 5)); }
__host__ __device__ __forceinline__ void stage_rc(int b, int& R, int& C) { const int st = b / 1024, sb = b % 1024, swz = sb ^ (((sb >> 9) & 1) << 5); R = (st >> 1) * 16 + swz / 64; C = (st & 1) * 32 + (swz % 64) / 2; }
__host__ __device__ __forceinline__ int perm32(int rho) { const int n = rho >> 4, i = rho & 15; return 8 * (i >> 2) + 4 * n + (i & 3); }

struct Unit { int pm, pn, kz; };
struct Gemm { const bf16_t* A; const bf16_t* Bt; int M, N, K, ld; };

struct StaticOrder {
    int nM, nN, nwg, G, c;
    __host__ __device__ void init(int M, int N, int G_, int c_) { nM = M / BM; nN = N / BM; nwg = nM * nN; G = G_; c = c_; }
    __host__ __device__ bool next(int i, Unit& u) const {
        const long L = (long)i * G + c; if (L >= nwg) return false;
        int wgid = (int)L; { const int q = nwg / NXCD, r = nwg % NXCD, xcd = wgid % NXCD, off = wgid / NXCD; wgid = (xcd < r ? xcd * (q + 1) : r * (q + 1) + (xcd - r) * q) + off; }
        const int nig = WGM * nN, gid = wgid / nig, fm = gid * WGM, gsz = (nM - fm) < WGM ? (nM - fm) : WGM;
        u.pm = fm + ((wgid % nig) % gsz); u.pn = (wgid % nig) / gsz; u.kz = 0; return true;
    }
    __device__ __forceinline__ void a_ready(const Unit&) const {}
    __device__ __forceinline__ void done(const Unit&) const {}
};

__device__ __forceinline__ unsigned cvt_pk_bf16(float lo, float hi) { unsigned r; asm volatile("v_cvt_pk_bf16_f32 %0, %1, %2" : "=v"(r) : "v"(lo), "v"(hi)); return r; }
typedef float f32x2 __attribute__((ext_vector_type(2)));
template <class Epi, class Sched, bool ALIGN_EPI = false, bool SP2 = false>
__device__ __forceinline__ void gemm_phase(PG8_LAS unsigned char* lds, const Gemm g, const Sched& S, const Epi& E) {
    int tid_ = threadIdx.x; asm volatile("" : "+v"(tid_));
    const int tid = tid_, wid = __builtin_amdgcn_readfirstlane(tid >> 6), lane = tid & 63, wr = wid >> 2, wc = wid & 3, fr = lane & 15, fq = lane >> 4;
    const int K = g.ld, nt = g.K / BK;
    unsigned voffA[2], voffB[2];
#pragma unroll
    for (int i = 0; i < 2; ++i) { int R, C; stage_rc(tid * 16 + i * 8192, R, C); const int Rb = Epi::PERM ? ((R & ~31) + perm32(R & 31)) : R;
        voffA[i] = (unsigned)(R * K + C) * 2u; voffB[i] = (unsigned)(Rb * K + C) * 2u; }
    const size_t kstep = (size_t)(BK * 2);
    const size_t hstep = (size_t)HALF * K * 2;
    const size_t tstep = 2 * hstep;
    const unsigned ldsw = (unsigned)wid * 1024u;
    const int aoff = lds_byte(wr * 64 + fr, fq * 8), boff = lds_byte(wc * 32 + fr, fq * 8);
#define PG8_SA(b, h) (((b) * 2 + (h)) * HTB)
#define PG8_SB(b, h) ((4 + (b) * 2 + (h)) * HTB)
#define PG8_STAGE(bufoff, gbase, voff) do { _Pragma("unroll") for (int _i = 0; _i < 2; ++_i) \
        __builtin_amdgcn_global_load_lds((const unsigned*)((const char*)(gbase) + (voff)[_i]), (PG8_LAS unsigned*)(lds + (bufoff) + ldsw + _i * 8192), 16, 0, 0); } while (0)
#define PG8_LDA(dst, b, h) do { _Pragma("unroll") for (int m = 0; m < 4; ++m) _Pragma("unroll") for (int k = 0; k < 2; ++k) dst[m][k] = *(const PG8_LAS bf16x8*)(lds + PG8_SA(b, h) + aoff + m * 2048 + k * 1024); } while (0)
#define PG8_LDB(dst, b, h) do { _Pragma("unroll") for (int n = 0; n < 2; ++n) _Pragma("unroll") for (int k = 0; k < 2; ++k) dst[n][k] = *(const PG8_LAS bf16x8*)(lds + PG8_SB(b, h) + boff + n * 2048 + k * 1024); } while (0)
#define PG8_MMA(ai, bj, At, Bt) do { __builtin_amdgcn_s_setprio(1); _Pragma("unroll") for (int m = 0; m < 4; ++m) _Pragma("unroll") for (int n = 0; n < 2; ++n) _Pragma("unroll") for (int k = 0; k < 2; ++k) \
        acc[ai][bj][m][n] = __builtin_amdgcn_mfma_f32_16x16x32_bf16(Bt[n][k], At[m][k], acc[ai][bj][m][n], 0, 0, 0); __builtin_amdgcn_s_setprio(0); } while (0)
#define PG8_WAIT_V(n) asm volatile("s_waitcnt vmcnt(" #n ")" ::: "memory")
#define PG8_WAIT_L(n) asm volatile("s_waitcnt lgkmcnt(" #n ")" ::: "memory")
#define PG8_BAR __builtin_amdgcn_s_barrier()
#define PG8_SCHED __builtin_amdgcn_sched_barrier(0)
    Unit cur, nxt; int ui = 0;
    if (!S.next(0, cur)) return;
    f32x4 acc[2][2][4][2];
#pragma unroll
    for (int a = 0; a < 2; ++a)
#pragma unroll
        for (int b = 0; b < 2; ++b)
#pragma unroll
            for (int m = 0; m < 4; ++m)
#pragma unroll
                for (int n = 0; n < 2; ++n) acc[a][b][m][n] = (f32x4){0.f, 0.f, 0.f, 0.f};
    bf16x8 At[4][2], B0[2][2], B1[2][2];
    const char* cA = (const char*)g.A + (size_t)cur.pm * tstep + (size_t)cur.kz * 2; const char* cB = (const char*)g.Bt + (size_t)cur.pn * tstep + (size_t)cur.kz * 2;
    S.a_ready(cur);
    if constexpr (SP2) {
        PG8_STAGE(PG8_SB(0, 0), cB, voffB); PG8_STAGE(PG8_SB(0, 1), cB + hstep, voffB); PG8_STAGE(PG8_SA(0, 0), cA, voffA); PG8_STAGE(PG8_SA(0, 1), cA + hstep, voffA);
        if (wr == 1) PG8_BAR;
        PG8_WAIT_V(2); PG8_BAR;
        PG8_STAGE(PG8_SB(1, 0), cB + kstep, voffB); PG8_STAGE(PG8_SA(1, 0), cA + kstep, voffA); PG8_STAGE(PG8_SB(1, 1), cB + hstep + kstep, voffB);
        PG8_WAIT_V(6); PG8_BAR;
    } else {
        PG8_STAGE(PG8_SB(0, 0), cB, voffB); PG8_STAGE(PG8_SA(0, 0), cA, voffA); PG8_STAGE(PG8_SB(0, 1), cB + hstep, voffB); PG8_STAGE(PG8_SA(0, 1), cA + hstep, voffA);
        if (wr == 1) PG8_BAR;
        PG8_WAIT_V(4); PG8_BAR;
        PG8_STAGE(PG8_SB(1, 0), cB + kstep, voffB); PG8_STAGE(PG8_SA(1, 0), cA + kstep, voffA); PG8_STAGE(PG8_SB(1, 1), cB + hstep + kstep, voffB);
        PG8_WAIT_V(6); PG8_BAR;
    }
    for (;;) {
        const bool has_next = S.next(ui + 1, nxt);
        const char* nA = has_next ? (const char*)g.A + (size_t)nxt.pm * tstep + (size_t)nxt.kz * 2 : cA; const char* nB = has_next ? (const char*)g.Bt + (size_t)nxt.pn * tstep + (size_t)nxt.kz * 2 : cB;
        for (int t = 0; t < nt; t += 2) {
            const bool last = (t == nt - 2);
            const char* a1 = cA + (size_t)(t + 1) * kstep;
            const char* a2 = last ? nA : cA + (size_t)(t + 2) * kstep; const char* b2 = last ? nB : cB + (size_t)(t + 2) * kstep;
            const char* a3 = a2 + kstep; const char* b3 = b2 + kstep;
            if (last && has_next) S.a_ready(nxt);
            if constexpr (SP2) {
            PG8_LDB(B0, 0, 0); PG8_LDB(B1, 0, 1); PG8_SCHED; PG8_LDA(At, 0, 0); PG8_STAGE(PG8_SA(1, 1), a1 + hstep, voffA);
            PG8_WAIT_V(8); PG8_WAIT_L(0); PG8_BAR; PG8_MMA(0, 0, At, B0); PG8_MMA(0, 1, At, B1); PG8_BAR; PG8_SCHED;
            PG8_LDA(At, 0, 1); PG8_STAGE(PG8_SB(0, 0), b2, voffB); PG8_STAGE(PG8_SB(0, 1), b2 + hstep, voffB); PG8_STAGE(PG8_SA(0, 0), a2, voffA);
            PG8_WAIT_V(8); PG8_WAIT_L(0); PG8_BAR; PG8_MMA(1, 0, At, B0); PG8_MMA(1, 1, At, B1); PG8_BAR; PG8_SCHED;
            PG8_LDB(B0, 1, 0); PG8_LDB(B1, 1, 1); PG8_SCHED; PG8_LDA(At, 1, 0); PG8_STAGE(PG8_SA(0, 1), a2 + hstep, voffA);
            PG8_WAIT_V(8); PG8_WAIT_L(0); PG8_BAR; PG8_MMA(0, 0, At, B0); PG8_MMA(0, 1, At, B1); PG8_BAR; PG8_SCHED;
            PG8_LDA(At, 1, 1); PG8_STAGE(PG8_SB(1, 0), b3, voffB); PG8_STAGE(PG8_SB(1, 1), b3 + hstep, voffB); PG8_STAGE(PG8_SA(1, 0), a3, voffA);
            PG8_WAIT_V(8); PG8_WAIT_L(0); PG8_BAR; PG8_MMA(1, 0, At, B0); PG8_MMA(1, 1, At, B1); PG8_BAR; PG8_SCHED;
            } else {
            PG8_LDB(B0, 0, 0); PG8_SCHED; PG8_LDA(At, 0, 0); PG8_STAGE(PG8_SA(1, 1), a1 + hstep, voffA);
            PG8_WAIT_L(8); PG8_BAR; PG8_WAIT_L(0); PG8_MMA(0, 0, At, B0); PG8_BAR; PG8_SCHED;
            PG8_LDB(B1, 0, 1); PG8_STAGE(PG8_SB(0, 0), b2, voffB);
            PG8_BAR; PG8_WAIT_L(0); PG8_MMA(0, 1, At, B1); PG8_BAR;
            PG8_LDA(At, 0, 1); PG8_STAGE(PG8_SA(0, 0), a2, voffA);
            PG8_BAR; PG8_WAIT_L(0); PG8_MMA(1, 0, At, B0); PG8_BAR; PG8_SCHED;
            PG8_STAGE(PG8_SB(0, 1), b2 + hstep, voffB);
            PG8_WAIT_V(6); PG8_BAR; PG8_MMA(1, 1, At, B1); PG8_BAR;
            PG8_LDB(B0, 1, 0); PG8_SCHED; PG8_LDA(At, 1, 0); PG8_STAGE(PG8_SA(0, 1), a2 + hstep, voffA);
            PG8_WAIT_L(8); PG8_BAR; PG8_WAIT_L(0); PG8_MMA(0, 0, At, B0); PG8_BAR; PG8_SCHED;
            PG8_LDB(B1, 1, 1); PG8_STAGE(PG8_SB(1, 0), b3, voffB);
            PG8_BAR; PG8_WAIT_L(0); PG8_MMA(0, 1, At, B1); PG8_BAR;
            PG8_LDA(At, 1, 1); PG8_STAGE(PG8_SA(1, 0), a3, voffA);
            PG8_BAR; PG8_WAIT_L(0); PG8_MMA(1, 0, At, B0); PG8_BAR; PG8_SCHED;
            PG8_STAGE(PG8_SB(1, 1), b3 + hstep, voffB);
            PG8_WAIT_V(6); PG8_BAR; PG8_MMA(1, 1, At, B1); PG8_BAR;
            }
        }
        if constexpr (ALIGN_EPI) { if (wr == 0) PG8_BAR; }
        if constexpr (!Epi::AFTER_DRAIN) { E(acc, cur, wr, wc, fr, fq); S.done(cur); }
        if (!has_next) break;
#pragma unroll
        for (int a = 0; a < 2; ++a)
#pragma unroll
            for (int b = 0; b < 2; ++b)
#pragma unroll
                for (int m = 0; m < 4; ++m)
#pragma unroll
                    for (int n = 0; n < 2; ++n) acc[a][b][m][n] = (f32x4){0.f, 0.f, 0.f, 0.f};
        cur = nxt; cA = nA; cB = nB; ++ui;
        if constexpr (ALIGN_EPI) { if (wr == 1) PG8_BAR; }
    }
    PG8_WAIT_V(0);
    if constexpr (!ALIGN_EPI) { if (wr == 0) PG8_BAR; }
    PG8_BAR;
    if constexpr (Epi::AFTER_DRAIN) { E.fused(acc, cur, wr, wc, fr, fq, lds, wid, lane); S.done(cur); }
#undef PG8_SA
#undef PG8_SB
#undef PG8_STAGE
#undef PG8_LDA
#undef PG8_LDB
#undef PG8_MMA
#undef PG8_WAIT_V
#undef PG8_WAIT_L
#undef PG8_BAR
#undef PG8_SCHED
}
}

namespace pg8 {
__device__ __forceinline__ float silu_f(float x) { return x * __builtin_amdgcn_rcpf(1.0f + __expf(-x)); }
struct EpiStore {
    static constexpr bool PERM = true, AFTER_DRAIN = false;
    bf16_t* O; int ldc; int ntn;
    __device__ __forceinline__ void operator()(const f32x4 (&acc)[2][2][4][2], const Unit& u, int wr, int wc, int fr, int fq) const {
        const int row0 = u.pm * BM + wr * 64 + fr; const int col0 = (u.pn % ntn) * BM + wc * 32 + 8 * fq;
#pragma unroll
        for (int ai = 0; ai < 2; ++ai)
#pragma unroll
            for (int m = 0; m < 4; ++m) { bf16_t* rowp = O + (size_t)(row0 + ai * HALF + m * 16) * ldc + col0;
#pragma unroll
                for (int bj = 0; bj < 2; ++bj) { const f32x4 v0 = acc[ai][bj][m][0], v1 = acc[ai][bj][m][1];
                    u32x4 w; w.x = cvt_pk_bf16(v0[0], v0[1]); w.y = cvt_pk_bf16(v0[2], v0[3]); w.z = cvt_pk_bf16(v1[0], v1[1]); w.w = cvt_pk_bf16(v1[2], v1[3]);
                    *(u32x4*)(rowp + bj * HALF) = w; } }
    }
};
struct EpiSwiglu {
    static constexpr bool PERM = true, AFTER_DRAIN = false;
    bf16_t* O; int ldc; int ntn;
    __device__ __forceinline__ void operator()(const f32x4 (&acc)[2][2][4][2], const Unit& u, int wr, int wc, int fr, int fq) const {
        const int row0 = u.pm * BM + wr * 64 + fr; const int col0 = (u.pn % ntn) * HALF + wc * 32 + 8 * fq;
#pragma unroll
        for (int ai = 0; ai < 2; ++ai)
#pragma unroll
            for (int m = 0; m < 4; ++m) { bf16_t* rowp = O + (size_t)(row0 + ai * HALF + m * 16) * ldc + col0;
                const f32x4 g0 = acc[ai][0][m][0], g1 = acc[ai][0][m][1], u0 = acc[ai][1][m][0], u1 = acc[ai][1][m][1];
                u32x4 w;
                w.x = cvt_pk_bf16(silu_f(g0[0]) * u0[0], silu_f(g0[1]) * u0[1]); w.y = cvt_pk_bf16(silu_f(g0[2]) * u0[2], silu_f(g0[3]) * u0[3]);
                w.z = cvt_pk_bf16(silu_f(g1[0]) * u1[0], silu_f(g1[1]) * u1[1]); w.w = cvt_pk_bf16(silu_f(g1[2]) * u1[2], silu_f(g1[3]) * u1[3]);
                *(u32x4*)rowp = w; asm volatile("" ::: "memory"); }
    }
};
struct MoeOrder {
    StaticOrder so; int nN; const volatile PG8_LAS int* pend;
    __device__ __forceinline__ bool next(int i, Unit& u) const {
        Unit t; if (!so.next(i, t)) return false;
        const int pm = t.pm;
        int e = 0;
#pragma unroll
        for (int j = 0; j < 8; ++j) e += (pend[j] <= pm);
        e = e > 7 ? 7 : e;
        u.pm = pm; u.pn = e * nN + t.pn; u.kz = 0; return true;
    }
    __device__ __forceinline__ void a_ready(const Unit&) const {}
    __device__ __forceinline__ void done(const Unit&) const {}
};
template <int NS, int KSLICE, int PM0, int NNT, int PN0, int NNE>
struct TailOrder {
    int nunits, G, c; const volatile PG8_LAS int* pend;
    __device__ __forceinline__ bool next(int i, Unit& u) const {
        const int L = i * G + c; if (L >= nunits * NS) return false;
        const int unit = L / NS, sl = L - unit * NS;
        const int pm = PM0 + unit / NNT, pl = unit % NNT;
        int e = 0;
        if (NNE > 0) {
#pragma unroll
            for (int j = 0; j < 8; ++j) e += (pend[j] <= pm);
            e = e > 7 ? 7 : e; }
        u.pm = pm; u.pn = PN0 + e * NNE + pl; u.kz = sl * KSLICE; return true;
    }
    __device__ __forceinline__ void a_ready(const Unit&) const {}
    __device__ __forceinline__ void done(const Unit&) const {}
};
template <int LDC, int PM0, int PN0, int NTN, int KSLICE>
struct EpiSlab {
    static constexpr bool PERM = false, AFTER_DRAIN = false;
    float* slab; size_t slab_stride;
    __device__ __forceinline__ void operator()(const f32x4 (&acc)[2][2][4][2], const Unit& u, int wr, int wc, int fr, int fq) const {
        float* out = slab + (size_t)(u.kz / KSLICE) * slab_stride;
        const int row0 = (u.pm - PM0) * BM + wr * 64 + fr; const int col0 = ((u.pn - PN0) % NTN) * BM + wc * 32 + 4 * fq;
#pragma unroll
        for (int ai = 0; ai < 2; ++ai)
#pragma unroll
            for (int m = 0; m < 4; ++m) { const size_t off = (size_t)(row0 + ai * HALF + m * 16) * LDC + col0;
#pragma unroll
                for (int bj = 0; bj < 2; ++bj)
#pragma unroll
                    for (int n = 0; n < 2; ++n) *(f32x4*)(out + off + bj * HALF + n * 16) = acc[ai][bj][m][n]; }
    }
};
}

constexpr int NB = 8, SEQ = 2048, DM = 1024, TT = NB * SEQ, INW = 2304, FF = 2816, NEXP = 8, DEPTH = 4;
constexpr int MOE_MAXBLK = (2 * TT) / 256 + NEXP;
constexpr float LN_EPS = 1e-5f;
constexpr int NWAVES = 8, NTHR = 512;
constexpr size_t MiB = 1u << 20;
constexpr size_t WS_CTL = 0, CTL_BYTES = 256 * 1024;
constexpr size_t WS_AGG = 512 * 1024;
constexpr size_t WS_WIN = 1 * MiB;
constexpr size_t WS_TOK = 5 * MiB + 512 * 1024;
constexpr size_t WS_WOUT = 6 * MiB;
constexpr size_t WS_WGU = 8 * MiB;
constexpr size_t WS_WD = 96 * MiB;
constexpr size_t WS_X = 140 * MiB;
constexpr size_t WS_XB = 204 * MiB;
constexpr size_t WS_H = 236 * MiB;
constexpr size_t WS_MIX = 308 * MiB;
constexpr size_t WS_HID = 340 * MiB;
constexpr size_t WS_ROWS = 527 * MiB;
constexpr size_t WS_SLAB = 595 * MiB;
constexpr size_t WS_END = 683 * MiB;
constexpr int CW_CNT = 0;
constexpr int CW_FLAG = 1024;
constexpr int CW_BAR = 4096;

constexpr int LDS_BYTES = 147456;
constexpr int MISC_OFF = 140 * 1024;

#define LAS __attribute__((address_space(3)))
typedef unsigned short bf16;
typedef unsigned v4u __attribute__((ext_vector_type(4)));
typedef unsigned v2u __attribute__((ext_vector_type(2)));
typedef float f32x4 __attribute__((ext_vector_type(4)));
typedef short bf16x8 __attribute__((ext_vector_type(8)));
typedef short s16x4 __attribute__((ext_vector_type(4)));
typedef float f32x16 __attribute__((ext_vector_type(16)));
#define RLX_AGENT __ATOMIC_RELAXED, __HIP_MEMORY_SCOPE_AGENT

__device__ __forceinline__ unsigned pk2(float lo, float hi) { return pg8::cvt_pk_bf16(lo, hi); }
__device__ __forceinline__ float bflo(unsigned w) { return __uint_as_float(w << 16); }
__device__ __forceinline__ float bfhi(unsigned w) { return __uint_as_float(w & 0xffff0000u); }
__device__ __forceinline__ float shfl_xor_l(float v, int o, int lane) { return __int_as_float(__builtin_amdgcn_ds_bpermute((lane ^ o) << 2, __float_as_int(v))); }
__device__ __forceinline__ float wave_sum(float v, int lane) {
#pragma unroll
    for (int o = 1; o < 64; o <<= 1) v += shfl_xor_l(v, o, lane);
    return v;
}

struct Params { const float* in[25]; float* out; unsigned char* ws; int pad0, pad1; };
enum { I_X = 0, I_WIN, I_WOUT, I_ALAM, I_ASUB, I_POOLW, I_POOLS, I_CONVW, I_CONVB, I_WA, I_BA, I_WI, I_BI, I_LLAM, I_LN1G, I_LN1B, I_LN2G, I_LN2B,
       I_FG, I_FU, I_FD, I_ROUT, I_MG, I_MU, I_MD };

struct Frame {
    LAS unsigned char* lds;
    int tid, lane, wave, vcu, G;
};
__device__ __forceinline__ int fresh_s(int v) { asm volatile("" : "+s"(v)); return v; }
__device__ __forceinline__ Frame refresh(const Frame& F0) {
    Frame F; int t = threadIdx.x; asm volatile("" : "+v"(t));
    int vc = F0.vcu, g = F0.G; asm volatile("" : "+s"(vc), "+s"(g));
    F.lds = F0.lds; F.tid = t; F.lane = t & 63; F.wave = __builtin_amdgcn_readfirstlane(t >> 6); F.vcu = vc; F.G = g; return F;
}

__device__ __forceinline__ void transpose_item(const float* W, int K, int N, bf16* WT, int mode, LAS float* scr, int item, int lane) {
    const int nblk = N / 32, kb = item / nblk, nb = item % nblk, k0 = 64 * kb, n0 = 32 * nb;
    const int r0 = mode == 0 ? n0 : ((n0 >> 7) * 256 + (n0 & 127) + (mode == 2 ? 128 : 0));
#pragma unroll 8
    for (int i = 0; i < 32; ++i) { const int kk = 2 * i + (lane >> 5); scr[kk * 33 + (lane & 31)] = W[(size_t)(k0 + kk) * N + n0 + (lane & 31)]; }
    asm volatile("s_waitcnt lgkmcnt(0)" ::: "memory");
    const int c = lane & 7;
#pragma unroll
    for (int j = 0; j < 4; ++j) { const int n = (lane >> 3) + 8 * j; const LAS float* s = scr + (8 * c) * 33 + n;
        v4u o; o.x = pk2(s[0 * 33], s[1 * 33]); o.y = pk2(s[2 * 33], s[3 * 33]); o.z = pk2(s[4 * 33], s[5 * 33]); o.w = pk2(s[6 * 33], s[7 * 33]);
        *(v4u*)(WT + (size_t)(r0 + n) * K + k0 + 8 * c) = o; }
    asm volatile("s_waitcnt lgkmcnt(0)" ::: "memory");
}

__device__ __forceinline__ void prep_layer(const Frame& F0, const Params& p, int l) {
    const Frame F = refresh(F0);
    unsigned char* ws = p.ws;
    LAS float* scr = (LAS float*)(F.lds + F.wave * 16384);
    const int gw = F.vcu * NWAVES + F.wave, NGW = F.G * NWAVES;
    const bool moe = (l & 1);
    const int nexp = moe ? NEXP : 1;
    constexpr int I_IN = 16 * 72, I_OUT = 16 * 32, I_G = 16 * 88, I_D = 44 * 32, I_E = 2 * I_G + I_D;
    const int nitems = I_IN + I_OUT + nexp * I_E;
    bf16* WIN = (bf16*)(ws + WS_WIN); bf16* WOUT = (bf16*)(ws + WS_WOUT); bf16* WGU = (bf16*)(ws + WS_WGU); bf16* WD = (bf16*)(ws + WS_WD);
    const float* win = p.in[I_WIN] + (size_t)l * DM * INW;
    const float* wout = p.in[I_WOUT] + (size_t)l * DM * DM;
    const size_t esz = (size_t)DM * FF;
    const float* fg = moe ? p.in[I_MG] + (size_t)(l >> 1) * NEXP * esz : p.in[I_FG] + (size_t)(l >> 1) * esz;
    const float* fu = moe ? p.in[I_MU] + (size_t)(l >> 1) * NEXP * esz : p.in[I_FU] + (size_t)(l >> 1) * esz;
    const float* fd = moe ? p.in[I_MD] + (size_t)(l >> 1) * NEXP * esz : p.in[I_FD] + (size_t)(l >> 1) * esz;
    for (int it = gw; it < nitems; it += NGW) {
        int r = it;
        if (r < I_IN) { transpose_item(win, DM, INW, WIN, 0, scr, r, F.lane); continue; } r -= I_IN;
        if (r < I_OUT) { const int kb = r / 32; if (kb < 8 || kb >= 12) transpose_item(wout, DM, DM, WOUT, 0, scr, r, F.lane); continue; } r -= I_OUT;
        const int e = r / I_E; r -= e * I_E;
        if (r < I_G) { transpose_item(fg + e * esz, DM, FF, WGU + (size_t)e * 2 * esz, 1, scr, r, F.lane); continue; } r -= I_G;
        if (r < I_G) { transpose_item(fu + e * esz, DM, FF, WGU + (size_t)e * 2 * esz, 2, scr, r, F.lane); continue; } r -= I_G;
        transpose_item(fd + e * esz, FF, DM, WD + (size_t)e * esz, 0, scr, r, F.lane);
    }
    {
        const float* pw = p.in[I_POOLW] + (size_t)l * 4 * 64 * 64; const float* ps = p.in[I_POOLS] + (size_t)l * 256;
        for (int idx = F.vcu * NTHR + F.tid; idx < 256 * 1024; idx += F.G * NTHR) {
            const int n = idx & 1023, kc = idx >> 10, g = kc >> 6;
            const float* pr = pw + (size_t)kc * 64; const float* sc = ps + g * 64; const float* wo = wout + (size_t)(512 + g * 64) * DM + n;
            float a = 0.f;
#pragma unroll 8
            for (int d = 0; d < 64; ++d) a += pr[d] * sc[d] * wo[(size_t)d * DM];
            WOUT[(size_t)n * DM + 512 + kc] = (bf16)(pk2(a, 0.f) & 0xffffu);
        }
    }
    if (l == 0) {
        const float* x = p.in[I_X]; bf16* XB = (bf16*)(ws + WS_XB);
        for (int m = gw; m < TT; m += NGW) {
            const f32x4* xr = (const f32x4*)(x + (size_t)m * DM) + F.lane; v2u* o = (v2u*)(XB + (size_t)m * DM) + F.lane;
#pragma unroll
            for (int j = 0; j < 4; ++j) { const f32x4 v = xr[64 * j]; v2u w; w.x = pk2(v.x, v.y); w.y = pk2(v.z, v.w); o[64 * j] = w; }
        }
    }
}

template <bool COMB, bool ROUTER>
__device__ __forceinline__ void ln_phase(const Frame& F0, const float* src, float* dst, bf16* XB, const float* gam, const float* bet, float alpha,
                                         const bf16* Y, int* tok, const float* wr, unsigned* cnt, int* blkbase, const float* slab) {
    const Frame F = refresh(F0);
    const int gw = F.vcu * NWAVES + F.wave, NGW = F.G * NWAVES;
    f32x4 gv[4], bv[4];
#pragma unroll
    for (int j = 0; j < 4; ++j) { gv[j] = *((const f32x4*)gam + F.lane + 64 * j); bv[j] = *((const f32x4*)bet + F.lane + 64 * j); }
    f32x4 rw[4][4][2];
    LAS unsigned* lcnt = (LAS unsigned*)(F.lds + MISC_OFF + 256);
    if (ROUTER) {
        if (F.tid < 8) lcnt[F.tid] = 0u;
        __syncthreads();
#pragma unroll
        for (int j = 0; j < 4; ++j)
#pragma unroll
            for (int i = 0; i < 4; ++i) { const int col = 4 * F.lane + 256 * j + i; rw[j][i][0] = *(const f32x4*)(wr + (size_t)col * 8); rw[j][i][1] = *(const f32x4*)(wr + (size_t)col * 8 + 4); }
    }
    for (int row = gw; row < TT; row += NGW) {
        f32x4 v[4];
#pragma unroll
        for (int j = 0; j < 4; ++j) v[j] = *((const f32x4*)(src + (size_t)row * DM) + F.lane + 64 * j);
        if (COMB) {
            const int d0 = tok[row * 8 + 6], d1 = tok[row * 8 + 7]; const float g0 = __int_as_float(tok[row * 8 + 4]), g1 = __int_as_float(tok[row * 8 + 5]);
#pragma unroll
            for (int k = 0; k < 2; ++k) {
                const int dd = k ? d1 : d0; const float gg = k ? g1 : g0;
                if (dd < 128 * 256) {
#pragma unroll
                    for (int j = 0; j < 4; ++j) { const v2u a = *((const v2u*)(Y + (size_t)dd * DM) + F.lane + 64 * j);
                        if (k == 0) v[j] = v[j] * alpha;
                        v[j].x += gg * bflo(a.x); v[j].y += gg * bfhi(a.x); v[j].z += gg * bflo(a.y); v[j].w += gg * bfhi(a.y); }
                } else {
                    f32x4 t[4];
#pragma unroll
                    for (int j = 0; j < 4; ++j) t[j] = (f32x4){0.f, 0.f, 0.f, 0.f};
                    for (int sl = 0; sl < 11; ++sl) {
#pragma unroll
                        for (int j = 0; j < 4; ++j) t[j] += *((const f32x4*)(slab + (size_t)sl * 2048 * DM + (size_t)(dd - 128 * 256) * DM) + F.lane + 64 * j); }
#pragma unroll
                    for (int j = 0; j < 4; ++j) { if (k == 0) v[j] = v[j] * alpha; v[j] += t[j] * gg; }
                }
            }
        }
        float s = 0.f;
#pragma unroll
        for (int j = 0; j < 4; ++j) s += (v[j].x + v[j].y) + (v[j].z + v[j].w);
        const float mean = wave_sum(s, F.lane) * (1.f / DM); float s2 = 0.f;
#pragma unroll
        for (int j = 0; j < 4; ++j) { v[j] = v[j] - mean; s2 += (v[j].x * v[j].x + v[j].y * v[j].y) + (v[j].z * v[j].z + v[j].w * v[j].w); }
        const float rstd = 1.f / sqrtf(wave_sum(s2, F.lane) * (1.f / DM) + LN_EPS);
#pragma unroll
        for (int j = 0; j < 4; ++j) {
            v[j] = v[j] * rstd * gv[j] + bv[j];
            *((f32x4*)(dst + (size_t)row * DM) + F.lane + 64 * j) = v[j];
            v2u w; w.x = pk2(v[j].x, v[j].y); w.y = pk2(v[j].z, v[j].w);
            *((v2u*)(XB + (size_t)row * DM) + F.lane + 64 * j) = w;
        }
        if (ROUTER) {
            float lg[8];
#pragma unroll
            for (int e = 0; e < 8; ++e) lg[e] = 0.f;
#pragma unroll
            for (int j = 0; j < 4; ++j)
#pragma unroll
                for (int i = 0; i < 4; ++i) {
                    const float xv = v[j][i];
                    const f32x4 w0 = rw[j][i][0], w1 = rw[j][i][1];
                    lg[0] += xv * w0.x; lg[1] += xv * w0.y; lg[2] += xv * w0.z; lg[3] += xv * w0.w;
                    lg[4] += xv * w1.x; lg[5] += xv * w1.y; lg[6] += xv * w1.z; lg[7] += xv * w1.w;
                }
#pragma unroll
            for (int e = 0; e < 8; ++e) lg[e] = wave_sum(lg[e], F.lane);
            int e0 = 0; float l0 = lg[0];
#pragma unroll
            for (int e = 1; e < 8; ++e) if (lg[e] > l0) { l0 = lg[e]; e0 = e; }
            int e1 = -1; float l1 = -INFINITY;
#pragma unroll
            for (int e = 0; e < 8; ++e) if (e != e0 && (e1 < 0 || lg[e] > l1)) { l1 = lg[e]; e1 = e; }
            const float ex = __expf(l1 - l0); const float g0 = 1.f / (1.f + ex), g1 = ex / (1.f + ex);
            if (F.lane == 0) {
                const unsigned r0 = __hip_atomic_fetch_add(lcnt + e0, 1u, __ATOMIC_RELAXED, __HIP_MEMORY_SCOPE_WORKGROUP), r1 = __hip_atomic_fetch_add(lcnt + e1, 1u, __ATOMIC_RELAXED, __HIP_MEMORY_SCOPE_WORKGROUP);
                int* t = tok + row * 8; t[0] = e0; t[1] = e1; t[2] = (int)r0; t[3] = (int)r1; t[4] = __float_as_int(g0); t[5] = __float_as_int(g1);
            }
        }
    }
    if (ROUTER) {
        __syncthreads();
        if (F.tid < 8) { const unsigned base = atomicAdd(cnt + F.tid, lcnt[F.tid]); blkbase[F.vcu * 8 + F.tid] = (int)base; }
    }
}

__device__ __forceinline__ void moe_layout(const Frame& F0, const unsigned* cnt) {
    const Frame F = refresh(F0);
    volatile LAS int* M = (volatile LAS int*)(F.lds + MISC_OFF);
    if (F.tid == 0) {
        int acc = 0;
#pragma unroll
        for (int e = 0; e < 8; ++e) { const unsigned c = __hip_atomic_load(cnt + e, RLX_AGENT); M[e] = acc * 256; acc += (int)((c + 255u) >> 8); M[8 + e] = acc; }
    }
    __syncthreads();
}
__device__ __forceinline__ void moe_gather(const Frame& F0, const bf16* XB, bf16* ROWS, int* tok, const int* blkbase) {
    const Frame F = refresh(F0);
    volatile LAS int* M = (volatile LAS int*)(F.lds + MISC_OFF);
    const int gw = F.vcu * NWAVES + F.wave, NGW = F.G * NWAVES;
    for (int t = gw; t < TT; t += NGW) {
        const int e0 = tok[t * 8 + 0], e1 = tok[t * 8 + 1], r0 = tok[t * 8 + 2], r1 = tok[t * 8 + 3];
        const int vb = ((t % NGW) >> 3) * 8;
        const int d0 = M[e0] + blkbase[vb + e0] + r0, d1 = M[e1] + blkbase[vb + e1] + r1;
        const v4u* s = (const v4u*)(XB + (size_t)t * DM) + F.lane; const v4u a = s[0], b = s[64];
        v4u* o0 = (v4u*)(ROWS + (size_t)d0 * DM) + F.lane; v4u* o1 = (v4u*)(ROWS + (size_t)d1 * DM) + F.lane;
        o0[0] = a; o0[64] = b; o1[0] = a; o1[64] = b;
        if (F.lane == 0) { tok[t * 8 + 6] = d0; tok[t * 8 + 7] = d1; }
    }
}

template <int G> __device__ __forceinline__ void pool_group(const Frame& F, const bf16* H, bf16* MIX) {
    constexpr int W = 2 << G;
    for (int idx = F.vcu * NTHR + F.tid; idx < TT * 8; idx += F.G * NTHR) {
        const int t = idx >> 3, c8 = idx & 7, ch = G * 64 + c8 * 8, pos = t & (SEQ - 1);
        const bf16* up = H + (size_t)t * INW + 1536 + ch;
        v4u v[W];
#pragma unroll
        for (int j = 0; j < W; ++j) { v[j] = (v4u){0u, 0u, 0u, 0u}; if (pos - j >= 0) v[j] = *(const v4u*)(up - (size_t)j * INW); }
        float s[8];
#pragma unroll
        for (int i = 0; i < 8; ++i) s[i] = 0.f;
#pragma unroll
        for (int j = 0; j < W; ++j) { s[0] += bflo(v[j].x); s[1] += bfhi(v[j].x); s[2] += bflo(v[j].y); s[3] += bfhi(v[j].y); s[4] += bflo(v[j].z); s[5] += bfhi(v[j].z); s[6] += bflo(v[j].w); s[7] += bfhi(v[j].w); }
        const int n = (pos + 1) < W ? (pos + 1) : W; const float inv = 1.f / (float)n;
        v4u o; o.x = pk2(s[0] * inv - bflo(v[0].x), s[1] * inv - bfhi(v[0].x)); o.y = pk2(s[2] * inv - bflo(v[0].y), s[3] * inv - bfhi(v[0].y));
        o.z = pk2(s[4] * inv - bflo(v[0].z), s[5] * inv - bfhi(v[0].z)); o.w = pk2(s[6] * inv - bflo(v[0].w), s[7] * inv - bfhi(v[0].w));
        *(v4u*)(MIX + (size_t)t * DM + 512 + ch) = o;
    }
}
__device__ __forceinline__ void pool_phase(const Frame& F0, const bf16* H, bf16* MIX) {
    const Frame F = refresh(F0);
    pool_group<0>(F, H, MIX); pool_group<1>(F, H, MIX); pool_group<2>(F, H, MIX); pool_group<3>(F, H, MIX);
}

__device__ __forceinline__ float sigmoid_f(float x) { return 1.f / (1.f + __expf(-x)); }
__device__ __forceinline__ float gelu_tanh(float x) { const float u = 0.7978845608028654f * (x + 0.044715f * x * x * x); const float t = 1.f - 2.f / (__expf(2.f * u) + 1.f); return 0.5f * x * (1.f + t); }
__device__ __forceinline__ void lru_phase(const Frame& F0, const Params& p, int l, const bf16* H, bf16* MIX, const float* XGS) {
    const Frame F = refresh(F0);
    constexpr int XCS = 68;
    LAS float* XC = (LAS float*)F.lds;
    LAS float* PB = (LAS float*)(F.lds + 69632);
    LAS float* AW = (LAS float*)(F.lds + 135168);
    LAS float* HW = (LAS float*)(F.lds + 135168 + 2048);
    LAS float* CIN = (LAS float*)(F.lds + 135168 + 4096);
    unsigned* flags = (unsigned*)(p.ws + WS_CTL) + CW_FLAG; float* agg = (float*)(p.ws + WS_AGG);
    const float* convw = p.in[I_CONVW] + (size_t)l * 4 * 256; const float* convb = p.in[I_CONVB] + (size_t)l * 256;
    for (int unit = F.vcu; unit < 256; unit += F.G) {
        const int seg = unit >> 5, bc = unit & 31, b = bc >> 2, cb = bc & 3;
        const size_t row0 = (size_t)b * SEQ + seg * 256;
        const int d = F.lane, chd = cb * 64 + d;
        unsigned short xgv[32];
#pragma unroll
        for (int tt = 0; tt < 32; ++tt) xgv[tt] = H[(row0 + F.wave * 32 + tt) * INW + 2048 + chd];
        __syncthreads();
        {
            const int c8 = F.tid & 7, ch = cb * 64 + c8 * 8;
            float cw[4][8], cbv[8];
#pragma unroll
            for (int i = 0; i < 8; ++i) { cbv[i] = convb[ch + i];
#pragma unroll
                for (int j = 0; j < 4; ++j) cw[j][i] = convw[j * 256 + ch + i]; }
#pragma unroll
            for (int it = 0; it < 4; ++it) {
                const int t = (F.tid >> 3) + 64 * it; const int pos = seg * 256 + t;
                float a[8];
#pragma unroll
                for (int i = 0; i < 8; ++i) a[i] = cbv[i];
#pragma unroll
                for (int j = 0; j < 4; ++j) {
                    if (pos - 3 + j >= 0) {
                        const v4u v = *(const v4u*)(H + (row0 + t - 3 + j) * INW + 1792 + ch);
                        a[0] += bflo(v.x) * cw[j][0]; a[1] += bfhi(v.x) * cw[j][1]; a[2] += bflo(v.y) * cw[j][2]; a[3] += bfhi(v.y) * cw[j][3];
                        a[4] += bflo(v.z) * cw[j][4]; a[5] += bfhi(v.z) * cw[j][5]; a[6] += bflo(v.w) * cw[j][6]; a[7] += bfhi(v.w) * cw[j][7];
                    }
                }
                LAS f32x4* o = (LAS f32x4*)(XC + t * XCS + c8 * 8);
                o[0] = (f32x4){a[0], a[1], a[2], a[3]}; o[1] = (f32x4){a[4], a[5], a[6], a[7]};
            }
        }
        __syncthreads();
        {
            const int col = F.lane & 31, hi = F.lane >> 5;
            const float* wa = p.in[I_WA] + (size_t)(l * 4 + cb) * 4096; const float* wi = p.in[I_WI] + (size_t)(l * 4 + cb) * 4096;
            bf16x8 fa[4], wfa[4][2], wfi[4][2];
#pragma unroll
            for (int ks = 0; ks < 4; ++ks)
#pragma unroll
                for (int hf = 0; hf < 2; ++hf) {
                    const float* sa = wa + (16 * ks + 8 * hi) * 64 + 32 * hf + col; const float* si = wi + (16 * ks + 8 * hi) * 64 + 32 * hf + col;
                    v4u w; w.x = pk2(sa[0], sa[64]); w.y = pk2(sa[128], sa[192]); w.z = pk2(sa[256], sa[320]); w.w = pk2(sa[384], sa[448]); wfa[ks][hf] = __builtin_bit_cast(bf16x8, w);
                    v4u u; u.x = pk2(si[0], si[64]); u.y = pk2(si[128], si[192]); u.z = pk2(si[256], si[320]); u.w = pk2(si[384], si[448]); wfi[ks][hf] = __builtin_bit_cast(bf16x8, u);
                }
            const LAS float* xr = XC + (32 * F.wave + col) * XCS + 8 * hi;
#pragma unroll
            for (int ks = 0; ks < 4; ++ks) { const f32x4 x0 = *(const LAS f32x4*)(xr + 16 * ks), x1 = *(const LAS f32x4*)(xr + 16 * ks + 4);
                v4u w; w.x = pk2(x0.x, x0.y); w.y = pk2(x0.z, x0.w); w.z = pk2(x1.x, x1.y); w.w = pk2(x1.z, x1.w); fa[ks] = __builtin_bit_cast(bf16x8, w); }
            f32x16 ra[2], ia[2];
#pragma unroll
            for (int hf = 0; hf < 2; ++hf)
#pragma unroll
                for (int r = 0; r < 16; ++r) { ra[hf][r] = 0.f; ia[hf][r] = 0.f; }
#pragma unroll
            for (int ks = 0; ks < 4; ++ks)
#pragma unroll
                for (int hf = 0; hf < 2; ++hf) {
                    ra[hf] = __builtin_amdgcn_mfma_f32_32x32x16_bf16(fa[ks], wfa[ks][hf], ra[hf], 0, 0, 0);
                    ia[hf] = __builtin_amdgcn_mfma_f32_32x32x16_bf16(fa[ks], wfi[ks][hf], ia[hf], 0, 0, 0);
                }
#pragma unroll
            for (int hf = 0; hf < 2; ++hf) {
                const int ch = cb * 64 + 32 * hf + col;
                const float ba = p.in[I_BA][l * 256 + ch], bi = p.in[I_BI][l * 256 + ch], lam = p.in[I_LLAM][l * 256 + ch];
                const float sp8 = -8.0f * log1pf(expf(-lam));
#pragma unroll
                for (int r = 0; r < 16; ++r) {
                    const int tk = 32 * F.wave + (r & 3) + 8 * (r >> 2) + 4 * hi;
                    const float xcd = XC[tk * XCS + 32 * hf + col];
                    const float rr = sigmoid_f(ra[hf][r] + ba), ii = sigmoid_f(ia[hf][r] + bi);
                    const float a = __expf(rr * sp8);
                    const float bt = sqrtf(fmaxf(1.0f - a * a, 0.f)) * (ii * xcd);
                    PB[tk * 64 + 32 * hf + col] = a; XC[tk * XCS + 32 * hf + col] = bt;
                }
            }
        }
        {
            float h = 0.f, P = 1.f;
#pragma unroll 8
            for (int tt = 0; tt < 32; ++tt) {
                const int t = F.wave * 32 + tt;
                const float a = PB[t * 64 + d], bt = XC[t * XCS + d];
                h = a * h + bt; P = a * P;
                XC[t * XCS + d] = h; PB[t * 64 + d] = P;
            }
            AW[F.wave * 64 + d] = P; HW[F.wave * 64 + d] = h;
        }
        __syncthreads();
        float Apre = 1.f, Hpre = 0.f, Ablk = 1.f, Hblk = 0.f;
#pragma unroll
        for (int v = 0; v < 8; ++v) { const float a = AW[v * 64 + d], hh = HW[v * 64 + d];
            if (v < F.wave) { Hpre = a * Hpre + hh; Apre = a * Apre; }
            Hblk = a * Hblk + hh; Ablk = a * Ablk; }
        if (F.wave == 0) {
            if (seg < 7) {
                __hip_atomic_store(agg + (size_t)unit * 128 + d, Ablk, RLX_AGENT); __hip_atomic_store(agg + (size_t)unit * 128 + 64 + d, Hblk, RLX_AGENT);
                asm volatile("s_waitcnt vmcnt(0)" ::: "memory");
                if (F.lane == 0) __hip_atomic_store(flags + unit, (unsigned)(l + 1), __ATOMIC_RELEASE, __HIP_MEMORY_SCOPE_AGENT);
            }
            if (seg > 0) {
                unsigned spins = 0;
                for (;;) {
                    const unsigned f = (F.lane < seg) ? __hip_atomic_load(flags + F.lane * 32 + bc, RLX_AGENT) : (unsigned)(l + 1);
                    if (__all(f >= (unsigned)(l + 1))) break;
                    __builtin_amdgcn_s_sleep(2); if (++spins > (1u << 22)) break;
                }
                __builtin_amdgcn_fence(__ATOMIC_ACQUIRE, "agent");
            }
            float pa[7], ph[7];
#pragma unroll
            for (int s = 0; s < 7; ++s) { pa[s] = 1.f; ph[s] = 0.f;
                if (s < seg) { pa[s] = __hip_atomic_load(agg + (size_t)(s * 32 + bc) * 128 + d, RLX_AGENT); ph[s] = __hip_atomic_load(agg + (size_t)(s * 32 + bc) * 128 + 64 + d, RLX_AGENT); } }
            float cin = 0.f;
#pragma unroll
            for (int s = 0; s < 7; ++s) cin = pa[s] * cin + ph[s];
            CIN[d] = cin;
        }
        __syncthreads();
        {
            const float cw = Apre * CIN[d] + Hpre;
#pragma unroll
            for (int tt = 0; tt < 32; ++tt) {
                const int t = F.wave * 32 + tt;
                const float hf = XC[t * XCS + d] + PB[t * 64 + d] * cw;
                const float xg = __uint_as_float((unsigned)xgv[tt] << 16);
                MIX[(row0 + t) * DM + 768 + chd] = (bf16)(pk2(hf * gelu_tanh(xg), 0.f) & 0xffffu);
            }
        }
    }
    __syncthreads();
}

constexpr int AK_STRIDE = 272, AV_STRIDE = 320, AK_BYTES = 64 * AK_STRIDE, AV_BYTES = 64 * AV_STRIDE, AOB_OFF = 40960;
constexpr float ATT_C = 0.125f * 1.4426950408889634f;
__device__ __forceinline__ s16x4 vtr(const LAS unsigned char* p) { typedef short v4i16_t __attribute__((ext_vector_type(4)));
    return __builtin_bit_cast(s16x4, __builtin_amdgcn_ds_read_tr16_b64_v4i16((LAS v4i16_t*)p)); }
__device__ __forceinline__ void attn_block(const Frame& F, const bf16* H, bf16* MIX, int b, int h, int qb, float lam, float omli, const float* subg) {
    const int tid = F.tid, lane = F.lane, wid = F.wave, m = wid >> 2, rg = wid & 3, ql = lane & 31, hi = lane >> 5;
    const int q0 = qb * 128; const size_t rowb = (size_t)b * SEQ;
    bf16x8 qr[4];
    { const bf16* qp = H + (rowb + q0 + 32 * rg + ql) * INW + h * 128 + m * 64 + 8 * hi;
#pragma unroll
      for (int d0 = 0; d0 < 4; ++d0) qr[d0] = *(const bf16x8*)(qp + 16 * d0); }
    const int NT = q0 / 64 + 2, nkv = (q0 + 32 * rg) / 64 + 1;
    f32x16 o[4];
#pragma unroll
    for (int i = 0; i < 4; ++i)
#pragma unroll
        for (int r = 0; r < 16; ++r) o[i][r] = 0.f;
    float mrun = -INFINITY, lrun = 0.f;
    const int lr = tid >> 4, lc = tid & 15;
    const bf16* kg = H + (rowb + lr) * INW + 512 + h * 128 + lc * 8;
    const bf16* vg = H + (rowb + lr) * INW + 1024 + h * 128 + lc * 8;
    LAS unsigned char* kd = F.lds + lr * AK_STRIDE + lc * 16; LAS unsigned char* vd = F.lds + AK_BYTES + lr * AV_STRIDE + lc * 16;
    v4u rk0, rk1, rv0, rv1;
    rk0 = *(const v4u*)kg; rk1 = *(const v4u*)(kg + (size_t)32 * INW); rv0 = *(const v4u*)vg; rv1 = *(const v4u*)(vg + (size_t)32 * INW);
    const LAS unsigned char* kb = F.lds + ql * AK_STRIDE + (m * 64 + 8 * hi) * 2;
    const LAS unsigned char* vb = F.lds + AK_BYTES + (4 * hi + ((lane >> 2) & 3)) * AV_STRIDE + (16 * ((lane >> 4) & 1) + 4 * (lane & 3)) * 2;
    for (int t = 0; t < NT; ++t) {
        __syncthreads();
        *(LAS v4u*)kd = rk0; *(LAS v4u*)(kd + 32 * AK_STRIDE) = rk1; *(LAS v4u*)vd = rv0; *(LAS v4u*)(vd + 32 * AV_STRIDE) = rv1;
        __syncthreads();
        if (t + 1 < NT) { const size_t off = (size_t)(t + 1) * 64 * INW;
            rk0 = *(const v4u*)(kg + off); rk1 = *(const v4u*)(kg + off + (size_t)32 * INW); rv0 = *(const v4u*)(vg + off); rv1 = *(const v4u*)(vg + off + (size_t)32 * INW); }
        if (t < nkv) {
            f32x16 p0, p1;
#pragma unroll
            for (int r = 0; r < 16; ++r) { p0[r] = 0.f; p1[r] = 0.f; }
#pragma unroll
            for (int d0 = 0; d0 < 4; ++d0) {
                const bf16x8 a0 = *(const LAS bf16x8*)(kb + d0 * 32), a1 = *(const LAS bf16x8*)(kb + 32 * AK_STRIDE + d0 * 32);
                p0 = __builtin_amdgcn_mfma_f32_32x32x16_bf16(a0, qr[d0], p0, 0, 0, 0);
                p1 = __builtin_amdgcn_mfma_f32_32x32x16_bf16(a1, qr[d0], p1, 0, 0, 0);
            }
            float mx = p0[0];
#pragma unroll
            for (int r = 0; r < 16; ++r) { mx = fmaxf(mx, p0[r]); mx = fmaxf(mx, p1[r]); }
            mx = fmaxf(mx, shfl_xor_l(mx, 32, lane));
            const float mnew = fmaxf(mrun, mx * ATT_C);
            const float al = __builtin_amdgcn_exp2f(mrun - mnew);
            float sum = 0.f;
#pragma unroll
            for (int r = 0; r < 16; ++r) { p0[r] = __builtin_amdgcn_exp2f(p0[r] * ATT_C - mnew); p1[r] = __builtin_amdgcn_exp2f(p1[r] * ATT_C - mnew); sum += p0[r] + p1[r]; }
            lrun = lrun * al + sum; mrun = mnew;
#pragma unroll
            for (int i = 0; i < 4; ++i)
#pragma unroll
                for (int r = 0; r < 16; ++r) o[i][r] *= al;
            bf16x8 pb[4];
#pragma unroll
            for (int j = 0; j < 4; ++j) {
                v4u w;
                if (j < 2) { w.x = pk2(p0[8 * j + 0], p0[8 * j + 1]); w.y = pk2(p0[8 * j + 2], p0[8 * j + 3]); w.z = pk2(p0[8 * j + 4], p0[8 * j + 5]); w.w = pk2(p0[8 * j + 6], p0[8 * j + 7]); }
                else { const int jj = j - 2; w.x = pk2(p1[8 * jj + 0], p1[8 * jj + 1]); w.y = pk2(p1[8 * jj + 2], p1[8 * jj + 3]); w.z = pk2(p1[8 * jj + 4], p1[8 * jj + 5]); w.w = pk2(p1[8 * jj + 6], p1[8 * jj + 7]); }
                pb[j] = __builtin_bit_cast(bf16x8, w);
            }
#pragma unroll
            for (int j = 0; j < 4; ++j)
#pragma unroll
                for (int db = 0; db < 4; ++db) {
                    const s16x4 lo = vtr(vb + j * 16 * AV_STRIDE + db * 64), hi4 = vtr(vb + j * 16 * AV_STRIDE + 8 * AV_STRIDE + db * 64);
                    const bf16x8 a = (bf16x8){lo[0], lo[1], lo[2], lo[3], hi4[0], hi4[1], hi4[2], hi4[3]};
                    o[db] = __builtin_amdgcn_mfma_f32_32x32x16_bf16(a, pb[j], o[db], 0, 0, 0);
                }
        }
    }
    lrun += shfl_xor_l(lrun, 32, lane);
    const float inv = 1.f / lrun;
    LAS float* ob = (LAS float*)(F.lds + AOB_OFF) + rg * 4096;
    if (m == 1) {
#pragma unroll
        for (int i = 0; i < 4; ++i)
#pragma unroll
            for (int r = 0; r < 16; ++r) ob[(i * 16 + r) * 64 + lane] = o[i][r] * inv;
    }
    __syncthreads();
    if (m == 0) {
        float ss = 0.f;
#pragma unroll
        for (int i = 0; i < 4; ++i)
#pragma unroll
            for (int r = 0; r < 16; ++r) { const float v = o[i][r] * inv - lam * ob[(i * 16 + r) * 64 + lane]; o[i][r] = v; ss += v * v; }
        ss += shfl_xor_l(ss, 32, lane);
        const float rinv = 1.0f / sqrtf(ss * (1.f / 128.f) + 1e-5f) * omli;
        bf16* op = MIX + (rowb + q0 + 32 * rg + ql) * DM + h * 128 + 4 * hi;
#pragma unroll
        for (int i = 0; i < 4; ++i)
#pragma unroll
            for (int rq = 0; rq < 4; ++rq) {
                const int dd = i * 32 + 8 * rq + 4 * hi; const f32x4 g = *(const f32x4*)(subg + dd);
                v2u w; w.x = pk2(o[i][4 * rq] * rinv * g.x, o[i][4 * rq + 1] * rinv * g.y); w.y = pk2(o[i][4 * rq + 2] * rinv * g.z, o[i][4 * rq + 3] * rinv * g.w);
                *(v2u*)(op + i * 32 + 8 * rq) = w;
            }
    }
}
__device__ __forceinline__ void attn_phase(const Frame& F0, const Params& p, int l, const bf16* H, bf16* MIX) {
    const Frame F = refresh(F0);
    const float* lv = p.in[I_ALAM] + (size_t)l * 256; const float* subg = p.in[I_ASUB] + (size_t)l * 128;
    const float linit = 0.8f - 0.6f * expf(-0.3f * (float)l);
    const float s01 = wave_sum(lv[F.lane] * lv[64 + F.lane], F.lane), s23 = wave_sum(lv[128 + F.lane] * lv[192 + F.lane], F.lane);
    const float lam = expf(s01) - expf(s23) + linit;
    for (int u = F.vcu; u < 256; u += F.G) {
        const int bh = u >> 3, s = u & 7, b = bh >> 2, h = bh & 3;
        attn_block(F, H, MIX, b, h, 15 - s, lam, 1.f - linit, subg);
        attn_block(F, H, MIX, b, h, s, lam, 1.f - linit, subg);
    }
    __syncthreads();
}

#define XB_TMO      128
#define XB_XCNT(j)  (256  + 64 * (j))
#define XB_XSUB(j)  (1280 + 64 * (j))
#define XB_XGEN(j)  (2304 + 64 * (j))
#define XB_TOP      3328
#define XB_TOPGEN   3392
#define XCD_BAR_WORDS 3456
#define XB_SPIN_CAP (1u << 18)

__device__ __forceinline__ unsigned xb_ld(unsigned* p)              { return __hip_atomic_load(p, __ATOMIC_RELAXED, __HIP_MEMORY_SCOPE_AGENT); }
__device__ __forceinline__ unsigned xb_add(unsigned* p, unsigned v) { return __hip_atomic_fetch_add(p, v, __ATOMIC_RELAXED, __HIP_MEMORY_SCOPE_AGENT); }
__device__ __forceinline__ unsigned xb_xcc_id() { return (unsigned)__builtin_amdgcn_s_getreg((3 << 11) | 20) & 0xFu; }
#define XB_SPIN(cond, bar) do { unsigned _sp = 0; while (cond) { __builtin_amdgcn_s_sleep(1); \
    if ((++_sp & 255u) == 0u) { if (xb_ld(&(bar)[XB_TMO])) break; if (_sp > XB_SPIN_CAP) { atomicAdd(&(bar)[XB_TMO], 1u); break; } } } } while (0)

struct XcdBarrier {
    unsigned* bar; unsigned x;
    volatile LAS unsigned* st;
};

__device__ __forceinline__ XcdBarrier xcd_barrier_post(unsigned* bar, volatile LAS unsigned* st) {
    XcdBarrier b; b.bar = bar; b.x = xb_xcc_id(); b.st = st;
    if (threadIdx.x == 0) (void)xb_add(&bar[XB_XCNT(b.x)], 1u);
    return b;
}
__device__ __forceinline__ void xcd_barrier_complete(unsigned* bar, unsigned x, unsigned& nloc, unsigned& nx) {
    const unsigned G = gridDim.x * gridDim.y * gridDim.z;
    unsigned sum, cnt, mine, sp = 0u;
    for (;;) {
        sum = 0u; cnt = 0u; mine = 0u;
#pragma unroll
        for (unsigned j = 0; j < 16; ++j) { const unsigned c = xb_ld(&bar[XB_XCNT(j)]); sum += c; cnt += (c > 0u) ? 1u : 0u; mine = (j == x) ? c : mine; }
        if (sum == G) break;
        __builtin_amdgcn_s_sleep(1);
        if ((++sp & 255u) == 0u) { if (xb_ld(&bar[XB_TMO])) break; if (sp > XB_SPIN_CAP) { atomicAdd(&bar[XB_TMO], 1u); break; } }
    }
    nloc = mine > 0u ? mine : 1u; nx = cnt > 0u ? cnt : 1u;
}

__device__ __forceinline__ void xcd_barrier(const XcdBarrier& b) {
    asm volatile("s_waitcnt vmcnt(0)" ::: "memory");
    __syncthreads();
    if (threadIdx.x == 0) {
        unsigned* bar = b.bar;
        __builtin_amdgcn_s_waitcnt(0);
        unsigned nloc = b.st[0], nx = b.st[1];
        if (nloc == 0u) { xcd_barrier_complete(bar, b.x, nloc, nx); b.st[0] = nloc; b.st[1] = nx; }
        const unsigned old = xb_add(&bar[XB_XSUB(b.x)], 1u);
        const unsigned gen = old / nloc;
        if (old + 1u == (gen + 1u) * nloc) {
            __builtin_amdgcn_fence(__ATOMIC_RELEASE, "agent");
            asm volatile("s_waitcnt vmcnt(0)" ::: "memory");
            const unsigned og = xb_add(&bar[XB_TOP], 1u);
            const unsigned tg = og / nx;
            if (og + 1u == (tg + 1u) * nx) xb_add(&bar[XB_TOPGEN], 1u);
            else XB_SPIN(xb_ld(&bar[XB_TOPGEN]) == tg, bar);
            __builtin_amdgcn_fence(__ATOMIC_ACQUIRE, "agent");
            xb_add(&bar[XB_XGEN(b.x)], 1u);
            asm volatile("s_waitcnt vmcnt(0)" ::: "memory");
        } else {
            XB_SPIN(xb_ld(&bar[XB_XGEN(b.x)]) == gen, bar);
            __builtin_amdgcn_fence(__ATOMIC_ACQUIRE, "agent");
            asm volatile("s_waitcnt vmcnt(0)" ::: "memory");
        }
    }
    __syncthreads();
}

typedef const __attribute__((address_space(4))) Params* kparams_ptr_t;
__device__ __forceinline__ const Params& kparams() { kparams_ptr_t kp = (kparams_ptr_t)__builtin_amdgcn_kernarg_segment_ptr(); asm volatile("" : "+s"(kp)); return *(const Params*)kp; }
#define WS_(T, off) ((T*)(kparams().ws + (off)))
#define P_X WS_(float, WS_X)
#define P_XB WS_(bf16, WS_XB)
#define P_H WS_(bf16, WS_H)
#define P_MIX WS_(bf16, WS_MIX)
#define P_HID WS_(bf16, WS_HID)
#define P_ROWS WS_(bf16, WS_ROWS)
#define P_Y WS_(bf16, WS_ROWS)
#define P_tok WS_(int, WS_TOK)
#define P_blkbase WS_(int, WS_AGG + 256 * 1024)
#define P_SLAB WS_(float, WS_SLAB)
#define P_WIN WS_(bf16, WS_WIN)
#define P_WOUT WS_(bf16, WS_WOUT)
#define P_WGU WS_(bf16, WS_WGU)
#define P_WD WS_(bf16, WS_WD)
#define P_ctl WS_(unsigned, WS_CTL)
namespace pg8 {
struct EpiResid {
    static constexpr bool PERM = false, AFTER_DRAIN = false;
    int first; float alpha;
    __device__ __forceinline__ void operator()(const f32x4 (&acc)[2][2][4][2], const Unit& u, int wr, int wc, int fr, int fq) const {
        const float* base = first ? kparams().in[I_X] : (const float*)WS_(float, WS_X); float* out = WS_(float, WS_X); constexpr int ldc = DM;
        const int row0 = u.pm * BM + wr * 64 + fr; const int col0 = u.pn * BM + wc * 32 + 4 * fq;
#pragma unroll
        for (int ai = 0; ai < 2; ++ai)
#pragma unroll
            for (int m = 0; m < 4; ++m) { const size_t off = (size_t)(row0 + ai * HALF + m * 16) * ldc + col0;
#pragma unroll
                for (int bj = 0; bj < 2; ++bj)
#pragma unroll
                    for (int n = 0; n < 2; ++n) { const f32x4 bs = *(const f32x4*)(base + off + bj * HALF + n * 16);
                        *(f32x4*)(out + off + bj * HALF + n * 16) = bs * alpha + acc[ai][bj][m][n]; }
                asm volatile("" ::: "memory"); }
    }
};
}
__global__ void __launch_bounds__(NTHR, 2) mega_fwd(Params p_unused) {
    extern __shared__ __attribute__((aligned(16))) unsigned char lds_raw[];
    cg::grid_group grid = cg::this_grid();
    Frame F;
    F.lds = (LAS unsigned char*)lds_raw;
    F.tid = threadIdx.x; F.lane = F.tid & 63; F.wave = __builtin_amdgcn_readfirstlane(F.tid >> 6);
    F.G = gridDim.x; { const int bx = blockIdx.x; F.vcu = (F.G % 8 == 0) ? (bx % 8) * (F.G / 8) + bx / 8 : bx; }
    const float alpha = 1.6817928305074290f;
    const int bx = (int)blockIdx.x;
    if (F.tid < 64) ((LAS unsigned*)(F.lds + MISC_OFF))[F.tid] = 0u;
    __syncthreads();
    (void)xcd_barrier_post(P_ctl + CW_BAR, (volatile LAS unsigned*)(F.lds + MISC_OFF) + 32);
#define PEND ((const volatile LAS int*)(F.lds + MISC_OFF) + 8)
#define GRID_BAR() do { XcdBarrier b_; b_.bar = P_ctl + CW_BAR; b_.x = xb_xcc_id(); b_.st = (volatile LAS unsigned*)(F.lds + MISC_OFF) + 32; xcd_barrier(b_); } while (0)

#ifndef NO_PREP
    prep_layer(F, kparams(), 0);
#ifdef PROBE_PREP
    prep_layer(F, kparams(), 1); prep_layer(F, kparams(), 2); prep_layer(F, kparams(), 3); prep_layer(F, kparams(), 0);
#endif
#endif
    grid.sync();
#ifdef PROBE_SYNC
    for (int i = 0; i < 32; ++i) GRID_BAR();
#endif
#pragma unroll 1
    for (int l = 0; l < DEPTH; ++l) {
        const bool moe = (l & 1);
        { pg8::Gemm g{P_XB, P_WIN, TT, INW, DM, DM}; pg8::StaticOrder S; S.init(TT, INW, fresh_s(F.G), fresh_s(bx));
          pg8::EpiStore E{P_H, INW, INW / 256};
          pg8::gemm_phase<pg8::EpiStore, pg8::StaticOrder, true, true>(F.lds, g, S, E);
        }
        GRID_BAR();
#ifndef NO_LRU
        lru_phase(F, kparams(), l, P_H, P_MIX, nullptr);
#ifdef PROBE_LRU
        lru_phase(F, kparams(), l, P_H, P_MIX, nullptr); pool_phase(F, P_H, P_MIX);
#endif
#endif
#ifndef NO_POOL
        pool_phase(F, P_H, P_MIX);
#endif
#ifndef NO_ATTN
        attn_phase(F, kparams(), l, P_H, P_MIX);
#ifdef PROBE_ATTN
        attn_phase(F, kparams(), l, P_H, P_MIX);
#endif
#endif
        GRID_BAR();
        { pg8::Gemm g{P_MIX, P_WOUT, TT, DM, DM, DM}; pg8::StaticOrder S; S.init(TT, DM, fresh_s(F.G), fresh_s(bx));
          pg8::EpiResid E{l == 0 ? 1 : 0, alpha};
#ifndef NO_G2
          pg8::gemm_phase<pg8::EpiResid, pg8::StaticOrder, true, true>(F.lds, g, S, E);
#endif
        }
        GRID_BAR();
        unsigned* cnt = P_ctl + CW_CNT + 64 * (l >> 1);
#ifndef NO_LN
        if (moe) ln_phase<false, true>(F, P_X, P_X, P_XB, kparams().in[I_LN1G] + l * DM, kparams().in[I_LN1B] + l * DM, alpha, nullptr, P_tok, kparams().in[I_ROUT] + (size_t)(l >> 1) * DM * 8, cnt, P_blkbase, nullptr);
        else ln_phase<false, false>(F, P_X, P_X, P_XB, kparams().in[I_LN1G] + l * DM, kparams().in[I_LN1B] + l * DM, alpha, nullptr, nullptr, nullptr, nullptr, nullptr, nullptr);
#endif
#ifdef PROBE_LN
        ln_phase<false, false>(F, P_X, (float*)P_HID, (bf16*)((unsigned char*)P_HID + 64 * MiB), kparams().in[I_LN1G] + l * DM, kparams().in[I_LN1B] + l * DM, alpha, nullptr, nullptr, nullptr, nullptr, nullptr, nullptr);
        ln_phase<false, false>(F, P_X, (float*)P_HID, (bf16*)((unsigned char*)P_HID + 64 * MiB), kparams().in[I_LN1G] + l * DM, kparams().in[I_LN1B] + l * DM, alpha, nullptr, nullptr, nullptr, nullptr, nullptr, nullptr);
#endif
        GRID_BAR();
        float* dst = (l == DEPTH - 1) ? kparams().out : P_X;
        if (!moe) {
            { pg8::Gemm g{P_XB, P_WGU, TT, 2 * FF, DM, DM}; pg8::StaticOrder S; S.init(TT, 2 * FF, fresh_s(F.G), fresh_s(bx));
              pg8::EpiSwiglu E{P_HID, FF, 2 * FF / 256};
#ifndef NO_G3
              pg8::gemm_phase<pg8::EpiSwiglu, pg8::StaticOrder, true, true>(F.lds, g, S, E);
#endif
#ifdef PROBE_G3
              pg8::gemm_phase<pg8::EpiSwiglu, pg8::StaticOrder, true, true>(F.lds, g, S, E);
#endif
        }
            GRID_BAR();
            { pg8::Gemm g{P_HID, P_WD, TT, DM, FF, FF}; pg8::StaticOrder S; S.init(TT, DM, fresh_s(F.G), fresh_s(bx));
              pg8::EpiResid E{0, alpha};
#ifndef NO_G4
              pg8::gemm_phase<pg8::EpiResid, pg8::StaticOrder, true, true>(F.lds, g, S, E);
#endif
        }
            GRID_BAR();
#ifndef NO_LN
            ln_phase<false, false>(F, P_X, dst, P_XB, kparams().in[I_LN2G] + l * DM, kparams().in[I_LN2B] + l * DM, alpha, nullptr, nullptr, nullptr, nullptr, nullptr, nullptr);
#endif
        } else {
            moe_layout(F, cnt);
#ifndef NO_GATHER
            moe_gather(F, P_XB, P_ROWS, P_tok, P_blkbase);
#endif
            GRID_BAR();
            { pg8::Gemm g{P_ROWS, P_WGU, MOE_MAXBLK * 256, 2 * FF, DM, DM}; pg8::MoeOrder S; S.so.init(PEND[7] * 256, 2 * FF, fresh_s(F.G), fresh_s(bx)); S.nN = 2 * FF / 256; S.pend = PEND;
              pg8::EpiSwiglu E{P_HID, FF, 2 * FF / 256};
#ifndef NO_G5
              pg8::gemm_phase<pg8::EpiSwiglu, pg8::MoeOrder, true, true>(F.lds, g, S, E);
#endif
#ifdef PROBE_MOE
              pg8::gemm_phase<pg8::EpiSwiglu, pg8::MoeOrder, true, true>(F.lds, g, S, E);
#endif
        }
            GRID_BAR();
            { pg8::Gemm g{P_HID, P_WD, MOE_MAXBLK * 256, DM, FF, FF}; pg8::MoeOrder S; S.so.init(128 * 256, DM, fresh_s(F.G), fresh_s(bx)); S.nN = DM / 256; S.pend = PEND;
              pg8::EpiStore E{P_Y, DM, DM / 256};
              pg8::gemm_phase<pg8::EpiStore, pg8::MoeOrder, true, true>(F.lds, g, S, E);
            }
            { pg8::Gemm g{P_HID, P_WD, MOE_MAXBLK * 256, DM, 256, FF}; typedef pg8::TailOrder<11, 256, 128, 4, 0, 4> MoeTail; MoeTail S{(PEND[7] - 128) * 4, fresh_s(F.G), fresh_s(bx), PEND};
              typedef pg8::EpiSlab<DM, 128, 0, 4, 256> MoeSlab; MoeSlab E{P_SLAB, (size_t)2048 * DM};
              pg8::gemm_phase<MoeSlab, MoeTail, true, true>(F.lds, g, S, E);
            }
            GRID_BAR();
#ifndef NO_LN
            ln_phase<true, false>(F, P_X, dst, P_XB, kparams().in[I_LN2G] + l * DM, kparams().in[I_LN2B] + l * DM, alpha, P_Y, P_tok, nullptr, nullptr, nullptr, P_SLAB);
#endif
        }
#ifndef NO_PREP
        if (l + 1 < DEPTH) { prep_layer(F, kparams(), l + 1); GRID_BAR(); }
#endif
    }
}

extern "C" void kernel_launch(void* const* d_in, const int* in_sizes, int n_in, void* d_out, int out_size, void* d_ws, size_t ws_size, hipStream_t stream) {
    static int grid = 0;
    if (grid == 0) {
        if (n_in != 25 || ws_size < WS_END) { fprintf(stderr, "kernel_launch: unexpected n_in %d / ws %zu\n", n_in, ws_size); grid = -1; return; }
        int dev = 0, cus = 0, per_cu = 0;
        hipGetDevice(&dev); hipDeviceGetAttribute(&cus, hipDeviceAttributeMultiprocessorCount, dev);
        hipFuncSetAttribute((const void*)mega_fwd, hipFuncAttributeMaxDynamicSharedMemorySize, LDS_BYTES);
        hipOccupancyMaxActiveBlocksPerMultiprocessor(&per_cu, (const void*)mega_fwd, NTHR, LDS_BYTES);
        if (per_cu < 1) { fprintf(stderr, "kernel_launch: occupancy query says %d blocks per CU\n", per_cu); per_cu = 1; }
        grid = cus * 1;
        (void)hipGetLastError();
    }
    if (grid < 0) return;
    hipMemsetAsync((char*)d_ws + WS_CTL, 0, CTL_BYTES, stream);
    Params p{};
    for (int i = 0; i < 25; ++i) p.in[i] = (const float*)d_in[i];
    p.out = (float*)d_out; p.ws = (unsigned char*)d_ws; p.pad0 = 0; p.pad1 = 0;
    void* args[] = {&p};
    hipError_t e = hipLaunchCooperativeKernel((const void*)mega_fwd, dim3(grid), dim3(NTHR), args, LDS_BYTES, stream);
    if (e != hipSuccess) fprintf(stderr, "cooperative launch failed: %s (grid %d)\n", hipGetErrorString(e), grid);
}
```
